# Optimizing an MI355X kernel written in HIP

```python
import math
import jax, jax.numpy as jnp
from jax import lax
import numpy as np

D_MODEL = 1024
BATCH = 2
SEQ = 8192
DEPTH = 4
DEC_BATCH = 128
DEC_SEQ = 8
PAST_LEN = 8192
PAGE_SIZE = 128

N_A_LAYERS = DEPTH // 2
N_B_LAYERS = DEPTH - N_A_LAYERS
A_HEADS = 4
A_DQK = D_MODEL // (2 * A_HEADS)
A_DV = D_MODEL // A_HEADS
A_QK_W = A_HEADS * A_DQK
A_V_W = A_HEADS * A_DV
A_PROJ = 2 * A_QK_W + 2 * A_V_W + 2 * A_HEADS
A_CHUNK = 64
GATE_CAP = 15.0
B_HEAD_DIM = 64
B_Q_HEADS = D_MODEL // B_HEAD_DIM
B_KV_HEADS = 4
B_GROUP = B_Q_HEADS // B_KV_HEADS
KV_WIDTH = B_KV_HEADS * B_HEAD_DIM
WINDOW = 128
ROT_DIM = B_HEAD_DIM // 4
ROPE_THETA = 500000.0
D_FF = 2816
EPS = 1e-6

kernel_name = "yoco_mlstm_swa_sink_macaron_step"


def rms_norm(x, g):
    xf = x.astype(jnp.float32)
    y = xf * lax.rsqrt(jnp.mean(xf * xf, axis=-1, keepdims=True) + EPS)
    return (y * g.astype(jnp.float32)).astype(x.dtype)


def swiglu(h, w_gate, w_up, w_down):
    return (jax.nn.silu(h @ w_gate) * (h @ w_up)) @ w_down


def partial_rope(x, pos):
    inv_freq = jnp.exp(-math.log(ROPE_THETA) * jnp.arange(0, ROT_DIM, 2, dtype=jnp.float32) / ROT_DIM)
    ang = pos.astype(jnp.float32)[:, None] * inv_freq[None, :]
    cos = jnp.cos(ang)[None, :, None, :]
    sin = jnp.sin(ang)[None, :, None, :]
    xr = x[..., :ROT_DIM].astype(jnp.float32)
    x1, x2 = xr[..., :ROT_DIM // 2], xr[..., ROT_DIM // 2:]
    rot = jnp.concatenate([x1 * cos - x2 * sin, x2 * cos + x1 * sin], axis=-1).astype(x.dtype)
    return jnp.concatenate([rot, x[..., ROT_DIM:]], axis=-1)


def mlstm_chunked(q, k, v, ig, lf, C0, n0, m0):
    B, S, H, _ = q.shape
    L = A_CHUNK if S % A_CHUNK == 0 else S
    NC = S // L

    def chunks(t):
        t = t.astype(jnp.float32).reshape((B, NC, L, H) + t.shape[3:])
        return jnp.swapaxes(jnp.moveaxis(t, 1, 0), 2, 3)

    tril = jnp.tril(jnp.ones((L, L), dtype=bool))

    def step(carry, xs):
        C, n, m = carry
        qc, kc, vc, ic, fc = xs
        b = jnp.cumsum(fc, axis=-1)
        dmat = jnp.where(tril, b[..., :, None] - b[..., None, :] + ic[..., None, :], -jnp.inf)
        g = b + m[..., None]
        mt = jnp.maximum(g, dmat.max(axis=-1))
        w_inter = jnp.exp(g - mt)
        s = jnp.einsum("bhtd,bhsd->bhts", qc, kc) * jnp.exp(dmat - mt[..., None])
        num = jnp.einsum("bhts,bhsv->bhtv", s, vc) + w_inter[..., None] * jnp.einsum("bhtd,bhdv->bhtv", qc, C)
        den = s.sum(axis=-1) + w_inter * jnp.einsum("bhtd,bhd->bht", qc, n)
        hc = num / jnp.maximum(jnp.abs(den), jnp.exp(-mt))[..., None]
        m_new = mt[..., -1]
        a = jnp.exp(b[..., -1:] - b + ic - m_new[..., None])
        decay = jnp.exp(b[..., -1] + m - m_new)
        C_new = decay[..., None, None] * C + jnp.einsum("bhs,bhsd,bhsv->bhdv", a, kc, vc)
        n_new = decay[..., None] * n + jnp.einsum("bhs,bhsd->bhd", a, kc)
        return (C_new, n_new, m_new), hc

    carry0 = (C0.astype(jnp.float32), n0.astype(jnp.float32), m0.astype(jnp.float32))
    (C, n, m), hs = lax.scan(step, carry0, (chunks(q), chunks(k), chunks(v), chunks(ig), chunks(lf)))
    h = jnp.swapaxes(jnp.moveaxis(hs, 0, 1), 2, 3).reshape(B, S, H, -1)
    return h, C.astype(C0.dtype), n.astype(n0.dtype), m.astype(m0.dtype)


def mlstm_mixer(h, w_in, b_gate, head_norm, w_out, C0, n0, m0):
    B, S, _ = h.shape
    proj = h @ w_in
    q, k, v, o, gates = jnp.split(proj, [A_QK_W, 2 * A_QK_W, 2 * A_QK_W + A_V_W, 2 * A_QK_W + 2 * A_V_W], axis=-1)
    gates = gates.astype(jnp.float32) + b_gate.astype(jnp.float32)
    gates = GATE_CAP * jnp.tanh(gates / GATE_CAP)
    ig = gates[..., :A_HEADS]
    lf = jax.nn.log_sigmoid(gates[..., A_HEADS:])
    q = q.reshape(B, S, A_HEADS, A_DQK)
    k = k.reshape(B, S, A_HEADS, A_DQK) * (A_DQK ** -0.5)
    v = v.reshape(B, S, A_HEADS, A_DV)
    hh, C, n, m = mlstm_chunked(q, k, v, ig, lf, C0, n0, m0)
    hh = rms_norm(hh, head_norm.reshape(A_HEADS, A_DV))
    hh = hh.reshape(B, S, A_V_W).astype(h.dtype) * jax.nn.sigmoid(o)
    return hh @ w_out, C, n, m


def sink_attention(q, k, v, q_pos, k_pos, sinks):
    s = jnp.einsum("bnqkgd,bnskd->bnkgqs", q, k).astype(jnp.float32) * (B_HEAD_DIM ** -0.5)
    diff = q_pos[:, :, None] - k_pos[:, None, :]
    mask = (diff >= 0) & (diff < WINDOW) & (k_pos[:, None, :] >= 0)
    s = jnp.where(mask[None, :, None, None, :, :], s, -jnp.inf)
    sk = sinks.astype(jnp.float32).reshape(B_KV_HEADS, B_GROUP)[None, None, :, :, None, None]
    mx = jnp.maximum(s.max(axis=-1, keepdims=True), sk)
    p = jnp.exp(s - mx)
    p = p / (p.sum(axis=-1, keepdims=True) + jnp.exp(sk - mx))
    return jnp.einsum("bnkgqs,bnskd->bnqkgd", p.astype(v.dtype), v)


def swa_banded(q, k, v, sinks):
    B, S = q.shape[:2]
    NB = S // WINDOW
    qb = q.reshape(B, NB, WINDOW, B_KV_HEADS, B_GROUP, B_HEAD_DIM)
    kb = k.reshape(B, NB, WINDOW, B_KV_HEADS, B_HEAD_DIM)
    vb = v.reshape(B, NB, WINDOW, B_KV_HEADS, B_HEAD_DIM)
    kk = jnp.concatenate([jnp.concatenate([jnp.zeros_like(kb[:, :1]), kb[:, :-1]], axis=1), kb], axis=2)
    vv = jnp.concatenate([jnp.concatenate([jnp.zeros_like(vb[:, :1]), vb[:, :-1]], axis=1), vb], axis=2)
    pos = jnp.arange(S, dtype=jnp.int32).reshape(NB, WINDOW)
    kpos = jnp.concatenate([pos - WINDOW, pos], axis=1)
    o = sink_attention(qb, kk, vv, pos, kpos, sinks)
    return o.reshape(B, S, B_Q_HEADS * B_HEAD_DIM)


def swa_direct(q, keys, vals, q_pos, k_pos, sinks):
    B, T = q.shape[:2]
    o = sink_attention(q.reshape(B, 1, T, B_KV_HEADS, B_GROUP, B_HEAD_DIM), keys[:, None], vals[:, None],
                       q_pos[None], k_pos[None], sinks)
    return o.reshape(B, T, B_Q_HEADS * B_HEAD_DIM)


def trunk(x, pos, C0, n0, m0, k_past, v_past, p):
    B, T, _ = x.shape
    new_C, new_n, new_m = [], [], []
    keys = vals = k_pos = buf_k = buf_v = None
    for l in range(DEPTH):
        if l == N_A_LAYERS:
            kv = rms_norm(x, p["kv_norm"]) @ p["w_kv"] + p["b_kv"]
            k_new = partial_rope(kv[..., :KV_WIDTH].reshape(B, T, B_KV_HEADS, B_HEAD_DIM), pos)
            v_new = kv[..., KV_WIDTH:].reshape(B, T, B_KV_HEADS, B_HEAD_DIM)
            if k_past is None:
                keys, vals = k_new, v_new
                wb = min(WINDOW, T)
            else:
                wb = k_past.shape[1]
                keys = jnp.concatenate([k_past, k_new], axis=1)
                vals = jnp.concatenate([v_past, v_new], axis=1)
                k_pos = jnp.concatenate([pos[0] - wb + jnp.arange(wb, dtype=jnp.int32), pos])
            buf_k, buf_v = keys[:, -wb:], vals[:, -wb:]
        x = x + 0.5 * swiglu(rms_norm(x, p["ffn_norm"][l, 0]), p["ffn_w_gate"][l, 0], p["ffn_w_up"][l, 0], p["ffn_w_down"][l, 0])
        h = rms_norm(x, p["mix_norm"][l])
        if l < N_A_LAYERS:
            y, C, n, m = mlstm_mixer(h, p["a_w_in"][l], p["a_b_gate"][l], p["a_head_norm"][l], p["a_w_out"][l], C0[l], n0[l], m0[l])
            new_C.append(C)
            new_n.append(n)
            new_m.append(m)
        else:
            j = l - N_A_LAYERS
            q = partial_rope((h @ p["b_w_q"][j] + p["b_b_q"][j]).reshape(B, T, B_Q_HEADS, B_HEAD_DIM), pos)
            if k_past is None:
                o = swa_banded(q, keys, vals, p["b_sinks"][j])
            else:
                o = swa_direct(q, keys, vals, pos, k_pos, p["b_sinks"][j])
            y = o @ p["b_w_o"][j] + p["b_b_o"][j]
        x = x + y
        x = x + 0.5 * swiglu(rms_norm(x, p["ffn_norm"][l, 1]), p["ffn_w_gate"][l, 1], p["ffn_w_up"][l, 1], p["ffn_w_down"][l, 1])
    return rms_norm(x, p["final_norm"]), jnp.stack(new_C), jnp.stack(new_n), jnp.stack(new_m), buf_k, buf_v


def setup_inputs(seed: int = 0) -> dict:
    key = jax.random.key(seed)
    ks = jax.random.split(key, 32)
    f32 = jnp.float32

    def nrm(k, shape, scale):
        return jax.random.normal(k, shape, f32) * scale

    WB = min(WINDOW, PAST_LEN)
    f_bias = jnp.linspace(3.0, 6.0, A_HEADS, dtype=f32)[None, :] + nrm(ks[14], (N_A_LAYERS, A_HEADS), 0.1)
    i_bias = nrm(ks[15], (N_A_LAYERS, A_HEADS), 0.1)
    return {
        "x_prompt": nrm(ks[0], (BATCH, SEQ, D_MODEL), 1.0),
        "x_sample": nrm(ks[1], (DEC_BATCH, DEC_SEQ, D_MODEL), 1.0),
        "state_mlstm_C": nrm(ks[2], (N_A_LAYERS, DEC_BATCH, A_HEADS, A_DQK, A_DV), 0.1),
        "state_mlstm_n": nrm(ks[3], (N_A_LAYERS, DEC_BATCH, A_HEADS, A_DQK), 0.1),
        "state_mlstm_m": nrm(ks[4], (N_A_LAYERS, DEC_BATCH, A_HEADS), 0.5),
        "cache_swa_k": nrm(ks[5], (DEC_BATCH, WB, B_KV_HEADS, B_HEAD_DIM), 1.0),
        "cache_swa_v": nrm(ks[6], (DEC_BATCH, WB, B_KV_HEADS, B_HEAD_DIM), 1.0),
        "ffn_norm": 1.0 + nrm(ks[7], (DEPTH, 2, D_MODEL), 0.02),
        "ffn_w_gate": nrm(ks[8], (DEPTH, 2, D_MODEL, D_FF), D_MODEL ** -0.5),
        "ffn_w_up": nrm(ks[9], (DEPTH, 2, D_MODEL, D_FF), D_MODEL ** -0.5),
        "ffn_w_down": nrm(ks[10], (DEPTH, 2, D_FF, D_MODEL), D_FF ** -0.5),
        "mix_norm": 1.0 + nrm(ks[11], (DEPTH, D_MODEL), 0.02),
        "a_w_in": nrm(ks[12], (N_A_LAYERS, D_MODEL, A_PROJ), D_MODEL ** -0.5),
        "a_b_gate": jnp.concatenate([i_bias, f_bias], axis=-1),
        "a_head_norm": 1.0 + nrm(ks[16], (N_A_LAYERS, A_V_W), 0.02),
        "a_w_out": nrm(ks[17], (N_A_LAYERS, A_V_W, D_MODEL), A_V_W ** -0.5),
        "kv_norm": 1.0 + nrm(ks[18], (D_MODEL,), 0.02),
        "w_kv": nrm(ks[19], (D_MODEL, 2 * KV_WIDTH), D_MODEL ** -0.5),
        "b_kv": nrm(ks[20], (2 * KV_WIDTH,), 0.02),
        "b_w_q": nrm(ks[21], (N_B_LAYERS, D_MODEL, B_Q_HEADS * B_HEAD_DIM), D_MODEL ** -0.5),
        "b_b_q": nrm(ks[22], (N_B_LAYERS, B_Q_HEADS * B_HEAD_DIM), 0.02),
        "b_sinks": nrm(ks[23], (N_B_LAYERS, B_Q_HEADS), 1.0),
        "b_w_o": nrm(ks[24], (N_B_LAYERS, B_Q_HEADS * B_HEAD_DIM, D_MODEL), (B_Q_HEADS * B_HEAD_DIM) ** -0.5),
        "b_b_o": nrm(ks[25], (N_B_LAYERS, D_MODEL), 0.02),
        "final_norm": 1.0 + nrm(ks[26], (D_MODEL,), 0.02),
    }


def reference(x_prompt, x_sample, state_mlstm_C, state_mlstm_n, state_mlstm_m, cache_swa_k, cache_swa_v,
              ffn_norm, ffn_w_gate, ffn_w_up, ffn_w_down, mix_norm, a_w_in, a_b_gate, a_head_norm, a_w_out,
              kv_norm, w_kv, b_kv, b_w_q, b_b_q, b_sinks, b_w_o, b_b_o, final_norm):
    p = {"ffn_norm": ffn_norm, "ffn_w_gate": ffn_w_gate, "ffn_w_up": ffn_w_up, "ffn_w_down": ffn_w_down,
         "mix_norm": mix_norm, "a_w_in": a_w_in, "a_b_gate": a_b_gate, "a_head_norm": a_head_norm,
         "a_w_out": a_w_out, "kv_norm": kv_norm, "w_kv": w_kv, "b_kv": b_kv, "b_w_q": b_w_q,
         "b_b_q": b_b_q, "b_sinks": b_sinks, "b_w_o": b_w_o, "b_b_o": b_b_o, "final_norm": final_norm}
    Bp, Sp, _ = x_prompt.shape
    Ts = x_sample.shape[1]
    zC = jnp.zeros((N_A_LAYERS, Bp, A_HEADS, A_DQK, A_DV), jnp.float32)
    zn = jnp.zeros((N_A_LAYERS, Bp, A_HEADS, A_DQK), jnp.float32)
    zm = jnp.zeros((N_A_LAYERS, Bp, A_HEADS), jnp.float32)
    y_prompt, p_C, p_n, p_m, p_k, p_v = trunk(x_prompt, jnp.arange(Sp, dtype=jnp.int32), zC, zn, zm, None, None, p)
    s_pos = PAST_LEN + jnp.arange(Ts, dtype=jnp.int32)
    y_sample, s_C, s_n, s_m, s_k, s_v = trunk(x_sample, s_pos, state_mlstm_C, state_mlstm_n, state_mlstm_m,
                                              cache_swa_k, cache_swa_v, p)
    return (y_prompt, y_sample, p_C, p_n, p_m, p_k, p_v, s_C, s_n, s_m, s_k, s_v)
```

```cpp
#include <hip/hip_runtime.h>
#include <hip/hip_cooperative_groups.h>
#include <cstdio>
#include <cstdint>
namespace cg = cooperative_groups;
namespace pg8 {
#define PG8_LAS __attribute__((address_space(3)))
typedef unsigned short bf16_t;
typedef short bf16x8 __attribute__((ext_vector_type(8)));
typedef float f32x4 __attribute__((ext_vector_type(4)));
typedef unsigned u32x4 __attribute__((ext_vector_type(4)));
constexpr int BM = 256, BK = 64, HALF = 128, HTB = HALF * BK * 2  , STAGE_BYTES = 8 * HTB, NXCD = 8, WGM = 8;

__host__ __device__ __forceinline__ int lds_byte(int r, int c) { const int st = (r >> 4) * 2 + (c >> 5), rr = r & 15, cc = c & 31, ob = rr * 64 + cc * 2; return st * 1024 + (ob ^ (((ob >> 9) & 1) << 5)); }
__host__ __device__ __forceinline__ void stage_rc(int b, int& R, int& C) { const int st = b / 1024, sb = b % 1024, swz = sb ^ (((sb >> 9) & 1) << 5); R = (st >> 1) * 16 + swz / 64; C = (st & 1) * 32 + (swz % 64) / 2; }
__host__ __device__ __forceinline__ int perm32(int rho) { const int n = rho >> 4, i = rho & 15; return 8 * (i >> 2) + 4 * n + (i & 3); }

struct Unit { int pm, pn; };
struct Gemm { const bf16_t* A; const bf16_t* Bt; int M, N, K, nt; };

struct StaticOrder {
    int nM, nN, nwg, G, c;
    __host__ __device__ void init(int M, int N, int G_, int c_) { nM = M / BM; nN = N / BM; nwg = nM * nN; G = G_; c = c_; }
    __host__ __device__ bool next(int i, Unit& u) const {
        const long L = (long)i * G + c; if (L >= nwg) return false;
        int wgid = (int)L; { const int q = nwg / NXCD, r = nwg % NXCD, xcd = wgid % NXCD, off = wgid / NXCD; wgid = (xcd < r ? xcd * (q + 1) : r * (q + 1) + (xcd - r) * q) + off; }
        const int nig = WGM * nN, gid = wgid / nig, fm = gid * WGM, gsz = (nM - fm) < WGM ? (nM - fm) : WGM;
        u.pm = fm + ((wgid % nig) % gsz); u.pn = (wgid % nig) / gsz; return true;
    }
    __device__ __forceinline__ void a_ready(const Unit&) const {}
    __device__ __forceinline__ void done(const Unit&) const {}
};

__device__ __forceinline__ unsigned cvt_pk_bf16(float lo, float hi) { unsigned r; asm volatile("v_cvt_pk_bf16_f32 %0, %1, %2" : "=v"(r) : "v"(lo), "v"(hi)); return r; }
typedef float f32x2 __attribute__((ext_vector_type(2)));
struct EpiBf16B {
    static constexpr bool PERM = true, AFTER_DRAIN = false;
    bf16_t* O; int ldc; const float* bias;
    __device__ __forceinline__ void operator()(const f32x4 (&acc)[2][2][4][2], const Unit& u, int wr, int wc, int fr, int fq) const {
        const int row0 = u.pm * BM + wr * 64 + fr; const int col0 = u.pn * BM + wc * 32 + 8 * fq;
        f32x4 bv[2][2];
#pragma unroll
        for (int bj = 0; bj < 2; ++bj)
#pragma unroll
            for (int n = 0; n < 2; ++n) bv[bj][n] = bias ? *(const f32x4*)(bias + col0 + bj * HALF + 4 * n) : (f32x4){0.f, 0.f, 0.f, 0.f};
#pragma unroll
        for (int ai = 0; ai < 2; ++ai)
#pragma unroll
            for (int m = 0; m < 4; ++m) { bf16_t* rowp = O + (size_t)(row0 + ai * HALF + m * 16) * ldc + col0;
#pragma unroll
                for (int bj = 0; bj < 2; ++bj) { const f32x4 v0 = acc[ai][bj][m][0] + bv[bj][0], v1 = acc[ai][bj][m][1] + bv[bj][1];
                    u32x4 w; w.x = cvt_pk_bf16(v0[0], v0[1]); w.y = cvt_pk_bf16(v0[2], v0[3]); w.z = cvt_pk_bf16(v1[0], v1[1]); w.w = cvt_pk_bf16(v1[2], v1[3]);
                    *(u32x4*)(rowp + bj * HALF) = w; } }
    }
};
__device__ __forceinline__ float silu_mul(float g, float u) { return g * u * __builtin_amdgcn_rcpf(1.0f + __builtin_amdgcn_exp2f(g * -1.4426950408889634f)); }
struct EpiSwiGLU {
    static constexpr bool PERM = true, AFTER_DRAIN = false;
    bf16_t* O; int ldc;
    __device__ __forceinline__ void operator()(const f32x4 (&acc)[2][2][4][2], const Unit& u, int wr, int wc, int fr, int fq) const {
        const int row0 = u.pm * BM + wr * 64 + fr; const int col0 = u.pn * HALF + wc * 32 + 8 * fq;
#pragma unroll
        for (int ai = 0; ai < 2; ++ai)
#pragma unroll
            for (int m = 0; m < 4; ++m) { bf16_t* rowp = O + (size_t)(row0 + ai * HALF + m * 16) * ldc + col0;
                const f32x4 g0 = acc[ai][0][m][0], g1 = acc[ai][0][m][1], u0 = acc[ai][1][m][0], u1 = acc[ai][1][m][1];
                u32x4 w; w.x = cvt_pk_bf16(silu_mul(g0[0], u0[0]), silu_mul(g0[1], u0[1])); w.y = cvt_pk_bf16(silu_mul(g0[2], u0[2]), silu_mul(g0[3], u0[3]));
                w.z = cvt_pk_bf16(silu_mul(g1[0], u1[0]), silu_mul(g1[1], u1[1])); w.w = cvt_pk_bf16(silu_mul(g1[2], u1[2]), silu_mul(g1[3], u1[3]));
                *(u32x4*)rowp = w; }
    }
};
struct EpiResid {
    static constexpr bool PERM = false, AFTER_DRAIN = false;
    float* X; int ldc; const float* bias; float scale;
    __device__ __forceinline__ void operator()(const f32x4 (&acc)[2][2][4][2], const Unit& u, int wr, int wc, int fr, int fq) const {
        const int col0 = u.pn * BM + wc * 32 + 4 * fq;
        f32x4 bv[2][2];
#pragma unroll
        for (int bj = 0; bj < 2; ++bj)
#pragma unroll
            for (int n = 0; n < 2; ++n) bv[bj][n] = bias ? *(const f32x4*)(bias + col0 + bj * HALF + n * 16) : (f32x4){0.f, 0.f, 0.f, 0.f};
#pragma unroll
        for (int ai = 0; ai < 2; ++ai) {
            float* base = X + (size_t)(u.pm * BM + ai * HALF + wr * 64 + fr) * ldc + col0;
            f32x4 old[4][2][2];
#pragma unroll
            for (int m = 0; m < 4; ++m)
#pragma unroll
                for (int bj = 0; bj < 2; ++bj)
#pragma unroll
                    for (int n = 0; n < 2; ++n) old[m][bj][n] = *(const f32x4*)(base + (size_t)(m * 16) * ldc + bj * HALF + n * 16);
#pragma unroll
            for (int m = 0; m < 4; ++m)
#pragma unroll
                for (int bj = 0; bj < 2; ++bj)
#pragma unroll
                    for (int n = 0; n < 2; ++n) *(f32x4*)(base + (size_t)(m * 16) * ldc + bj * HALF + n * 16) = old[m][bj][n] + (acc[ai][bj][m][n] + bv[bj][n]) * scale;
            asm volatile("" ::: "memory"); }
    }
};
struct EpiF32 {
    static constexpr bool PERM = false, AFTER_DRAIN = false;
    float* O; int ldc; const float* bias;
    __device__ __forceinline__ void operator()(const f32x4 (&acc)[2][2][4][2], const Unit& u, int wr, int wc, int fr, int fq) const {
        const int col0 = u.pn * BM + wc * 32 + 4 * fq;
#pragma unroll
        for (int ai = 0; ai < 2; ++ai)
#pragma unroll
            for (int m = 0; m < 4; ++m) { float* rowp = O + (size_t)(u.pm * BM + ai * HALF + wr * 64 + m * 16 + fr) * ldc + col0;
#pragma unroll
                for (int bj = 0; bj < 2; ++bj)
#pragma unroll
                    for (int n = 0; n < 2; ++n) { const f32x4 bvv = *(const f32x4*)(bias + col0 + bj * HALF + n * 16); *(f32x4*)(rowp + bj * HALF + n * 16) = acc[ai][bj][m][n] + bvv; } }
    }
};
struct OneUnit {
    int pm, pn; bool has;
    __device__ __forceinline__ bool next(int i, Unit& u) const { if (i == 0 && has) { u.pm = pm; u.pn = pn; return true; } return false; }
    __device__ __forceinline__ void a_ready(const Unit&) const {}
    __device__ __forceinline__ void done(const Unit&) const {}
};
struct EpiPartial {
    static constexpr bool PERM = false, AFTER_DRAIN = false;
    float* P; const float* bias; float scale; bool addbias;
    __device__ __forceinline__ void operator()(const f32x4 (&acc)[2][2][4][2], const Unit& u, int wr, int wc, int fr, int fq) const {
        const int col0 = u.pn * BM + wc * 32 + 4 * fq;
        f32x4 bv[2][2];
#pragma unroll
        for (int bj = 0; bj < 2; ++bj)
#pragma unroll
            for (int n = 0; n < 2; ++n) bv[bj][n] = (bias && addbias) ? *(const f32x4*)(bias + col0 + bj * HALF + n * 16) : (f32x4){0.f, 0.f, 0.f, 0.f};
#pragma unroll
        for (int ai = 0; ai < 2; ++ai)
#pragma unroll
            for (int m = 0; m < 4; ++m) { float* rowp = P + (size_t)((u.pm - 64) * BM + ai * HALF + wr * 64 + m * 16 + fr) * 1024 + col0;
#pragma unroll
                for (int bj = 0; bj < 2; ++bj)
#pragma unroll
                    for (int n = 0; n < 2; ++n) *(f32x4*)(rowp + bj * HALF + n * 16) = (acc[ai][bj][m][n] + bv[bj][n]) * scale; }
    }
};
template <class Epi, class Sched, bool ALIGN_EPI = false, bool SP2 = false>
__device__ __forceinline__ void gemm_phase(PG8_LAS unsigned char* lds, const Gemm g, const Sched& S, const Epi& E, const int tid_in) {
    const int tid = tid_in, wid = __builtin_amdgcn_readfirstlane(tid >> 6), lane = tid & 63, wr = wid >> 2, wc = wid & 3, fr = lane & 15, fq = lane >> 4;
    const int K = g.K, nt = g.nt;
    unsigned voffA[2], voffB[2];
#pragma unroll
    for (int i = 0; i < 2; ++i) { int R, C; stage_rc(tid * 16 + i * 8192, R, C); const int Rb = Epi::PERM ? ((R & ~31) + perm32(R & 31)) : R;
        voffA[i] = (unsigned)(R * K + C) * 2u; voffB[i] = (unsigned)(Rb * K + C) * 2u; }
    const size_t kstep = (size_t)(BK * 2);
    const size_t hstep = (size_t)HALF * K * 2;
    const size_t tstep = 2 * hstep;
    const unsigned ldsw = (unsigned)wid * 1024u;
    const int aoff = lds_byte(wr * 64 + fr, fq * 8), boff = lds_byte(wc * 32 + fr, fq * 8);
#define PG8_SA(b, h) (((b) * 2 + (h)) * HTB)
#define PG8_SB(b, h) ((4 + (b) * 2 + (h)) * HTB)
#define PG8_STAGE(bufoff, gbase, voff) do { _Pragma("unroll") for (int _i = 0; _i < 2; ++_i) \
        __builtin_amdgcn_global_load_lds((const unsigned*)((const char*)(gbase) + (voff)[_i]), (PG8_LAS unsigned*)(lds + (bufoff) + ldsw + _i * 8192), 16, 0, 0); } while (0)
#define PG8_LDA(dst, b, h) do { _Pragma("unroll") for (int m = 0; m < 4; ++m) _Pragma("unroll") for (int k = 0; k < 2; ++k) dst[m][k] = *(const PG8_LAS bf16x8*)(lds + PG8_SA(b, h) + aoff + m * 2048 + k * 1024); } while (0)
#define PG8_LDB(dst, b, h) do { _Pragma("unroll") for (int n = 0; n < 2; ++n) _Pragma("unroll") for (int k = 0; k < 2; ++k) dst[n][k] = *(const PG8_LAS bf16x8*)(lds + PG8_SB(b, h) + boff + n * 2048 + k * 1024); } while (0)
#define PG8_MMA(ai, bj, At, Bt) do { __builtin_amdgcn_s_setprio(1); _Pragma("unroll") for (int m = 0; m < 4; ++m) _Pragma("unroll") for (int n = 0; n < 2; ++n) _Pragma("unroll") for (int k = 0; k < 2; ++k) \
        acc[ai][bj][m][n] = __builtin_amdgcn_mfma_f32_16x16x32_bf16(Bt[n][k], At[m][k], acc[ai][bj][m][n], 0, 0, 0); __builtin_amdgcn_s_setprio(0); } while (0)
#define PG8_WAIT_V(n) asm volatile("s_waitcnt vmcnt(" #n ")" ::: "memory")
#define PG8_WAIT_L(n) asm volatile("s_waitcnt lgkmcnt(" #n ")" ::: "memory")
#define PG8_BAR __builtin_amdgcn_s_barrier()
#define PG8_SCHED __builtin_amdgcn_sched_barrier(0)
    Unit cur, nxt; int ui = 0;
    if (!S.next(0, cur)) return;
    f32x4 acc[2][2][4][2];
#pragma unroll
    for (int a = 0; a < 2; ++a)
#pragma unroll
        for (int b = 0; b < 2; ++b)
#pragma unroll
            for (int m = 0; m < 4; ++m)
#pragma unroll
                for (int n = 0; n < 2; ++n) acc[a][b][m][n] = (f32x4){0.f, 0.f, 0.f, 0.f};
    bf16x8 At[4][2], B0[2][2], B1[2][2];
    const char* cA = (const char*)g.A + (size_t)cur.pm * tstep; const char* cB = (const char*)g.Bt + (size_t)cur.pn * tstep;
    S.a_ready(cur);
    if constexpr (SP2) {
        PG8_STAGE(PG8_SB(0, 0), cB, voffB); PG8_STAGE(PG8_SB(0, 1), cB + hstep, voffB); PG8_STAGE(PG8_SA(0, 0), cA, voffA); PG8_STAGE(PG8_SA(0, 1), cA + hstep, voffA);
        if (wr == 1) PG8_BAR;
        PG8_WAIT_V(2); PG8_BAR;
        PG8_STAGE(PG8_SB(1, 0), cB + kstep, voffB); PG8_STAGE(PG8_SA(1, 0), cA + kstep, voffA); PG8_STAGE(PG8_SB(1, 1), cB + hstep + kstep, voffB);
        PG8_WAIT_V(6); PG8_BAR;
    } else {
        PG8_STAGE(PG8_SB(0, 0), cB, voffB); PG8_STAGE(PG8_SA(0, 0), cA, voffA); PG8_STAGE(PG8_SB(0, 1), cB + hstep, voffB); PG8_STAGE(PG8_SA(0, 1), cA + hstep, voffA);
        if (wr == 1) PG8_BAR;
        PG8_WAIT_V(4); PG8_BAR;
        PG8_STAGE(PG8_SB(1, 0), cB + kstep, voffB); PG8_STAGE(PG8_SA(1, 0), cA + kstep, voffA); PG8_STAGE(PG8_SB(1, 1), cB + hstep + kstep, voffB);
        PG8_WAIT_V(6); PG8_BAR;
    }
    for (;;) {
        const bool has_next = S.next(ui + 1, nxt);
        const char* nA = has_next ? (const char*)g.A + (size_t)nxt.pm * tstep : cA; const char* nB = has_next ? (const char*)g.Bt + (size_t)nxt.pn * tstep : cB;
        for (int t = 0; t < nt; t += 2) {
            const bool last = (t == nt - 2);
            const char* a1 = cA + (size_t)(t + 1) * kstep;
            const char* a2 = last ? nA : cA + (size_t)(t + 2) * kstep; const char* b2 = last ? nB : cB + (size_t)(t + 2) * kstep;
            const char* a3 = a2 + kstep; const char* b3 = b2 + kstep;
            if (last && has_next) S.a_ready(nxt);
            if constexpr (SP2) {
            PG8_LDB(B0, 0, 0); PG8_LDB(B1, 0, 1); PG8_SCHED; PG8_LDA(At, 0, 0); PG8_STAGE(PG8_SA(1, 1), a1 + hstep, voffA);
            PG8_WAIT_V(8); PG8_WAIT_L(0); PG8_BAR; PG8_MMA(0, 0, At, B0); PG8_MMA(0, 1, At, B1); PG8_BAR; PG8_SCHED;
            PG8_LDA(At, 0, 1); PG8_STAGE(PG8_SB(0, 0), b2, voffB); PG8_STAGE(PG8_SB(0, 1), b2 + hstep, voffB); PG8_STAGE(PG8_SA(0, 0), a2, voffA);
            PG8_WAIT_V(8); PG8_WAIT_L(0); PG8_BAR; PG8_MMA(1, 0, At, B0); PG8_MMA(1, 1, At, B1); PG8_BAR; PG8_SCHED;
            PG8_LDB(B0, 1, 0); PG8_LDB(B1, 1, 1); PG8_SCHED; PG8_LDA(At, 1, 0); PG8_STAGE(PG8_SA(0, 1), a2 + hstep, voffA);
            PG8_WAIT_V(8); PG8_WAIT_L(0); PG8_BAR; PG8_MMA(0, 0, At, B0); PG8_MMA(0, 1, At, B1); PG8_BAR; PG8_SCHED;
            PG8_LDA(At, 1, 1); PG8_STAGE(PG8_SB(1, 0), b3, voffB); PG8_STAGE(PG8_SB(1, 1), b3 + hstep, voffB); PG8_STAGE(PG8_SA(1, 0), a3, voffA);
            PG8_WAIT_V(8); PG8_WAIT_L(0); PG8_BAR; PG8_MMA(1, 0, At, B0); PG8_MMA(1, 1, At, B1); PG8_BAR; PG8_SCHED;
            } else {
            PG8_LDB(B0, 0, 0); PG8_SCHED; PG8_LDA(At, 0, 0); PG8_STAGE(PG8_SA(1, 1), a1 + hstep, voffA);
            PG8_WAIT_L(8); PG8_BAR; PG8_WAIT_L(0); PG8_MMA(0, 0, At, B0); PG8_BAR; PG8_SCHED;
            PG8_LDB(B1, 0, 1); PG8_STAGE(PG8_SB(0, 0), b2, voffB);
            PG8_BAR; PG8_WAIT_L(0); PG8_MMA(0, 1, At, B1); PG8_BAR;
            PG8_LDA(At, 0, 1); PG8_STAGE(PG8_SA(0, 0), a2, voffA);
            PG8_BAR; PG8_WAIT_L(0); PG8_MMA(1, 0, At, B0); PG8_BAR; PG8_SCHED;
            PG8_STAGE(PG8_SB(0, 1), b2 + hstep, voffB);
            PG8_WAIT_V(6); PG8_BAR; PG8_MMA(1, 1, At, B1); PG8_BAR;
            PG8_LDB(B0, 1, 0); PG8_SCHED; PG8_LDA(At, 1, 0); PG8_STAGE(PG8_SA(0, 1), a2 + hstep, voffA);
            PG8_WAIT_L(8); PG8_BAR; PG8_WAIT_L(0); PG8_MMA(0, 0, At, B0); PG8_BAR; PG8_SCHED;
            PG8_LDB(B1, 1, 1); PG8_STAGE(PG8_SB(1, 0), b3, voffB);
            PG8_BAR; PG8_WAIT_L(0); PG8_MMA(0, 1, At, B1); PG8_BAR;
            PG8_LDA(At, 1, 1); PG8_STAGE(PG8_SA(1, 0), a3, voffA);
            PG8_BAR; PG8_WAIT_L(0); PG8_MMA(1, 0, At, B0); PG8_BAR; PG8_SCHED;
            PG8_STAGE(PG8_SB(1, 1), b3 + hstep, voffB);
            PG8_WAIT_V(6); PG8_BAR; PG8_MMA(1, 1, At, B1); PG8_BAR;
            }
        }
        if constexpr (ALIGN_EPI) { if (wr == 0) PG8_BAR; }
        if constexpr (!Epi::AFTER_DRAIN) { E(acc, cur, wr, wc, fr, fq); S.done(cur); }
        if (!has_next) break;
#pragma unroll
        for (int a = 0; a < 2; ++a)
#pragma unroll
            for (int b = 0; b < 2; ++b)
#pragma unroll
                for (int m = 0; m < 4; ++m)
#pragma unroll
                    for (int n = 0; n < 2; ++n) acc[a][b][m][n] = (f32x4){0.f, 0.f, 0.f, 0.f};
        cur = nxt; cA = nA; cB = nB; ++ui;
        if constexpr (ALIGN_EPI) { if (wr == 1) PG8_BAR; }
    }
    PG8_WAIT_V(0);
    if constexpr (!ALIGN_EPI) { if (wr == 0) PG8_BAR; }
    PG8_BAR;
    if constexpr (Epi::AFTER_DRAIN) { E.fused(acc, cur, wr, wc, fr, fq, lds, wid, lane); S.done(cur); }
#undef PG8_SA
#undef PG8_SB
#undef PG8_STAGE
#undef PG8_LDA
#undef PG8_LDB
#undef PG8_MMA
#undef PG8_WAIT_V
#undef PG8_WAIT_L
#undef PG8_BAR
#undef PG8_SCHED
}
}

#define LAS __attribute__((address_space(3)))
typedef unsigned short bf16;
typedef unsigned u32x4 __attribute__((ext_vector_type(4)));
typedef unsigned u32x2 __attribute__((ext_vector_type(2)));
typedef float f32x4 __attribute__((ext_vector_type(4)));
typedef float f32x2v __attribute__((ext_vector_type(2)));
typedef short bf16x8 __attribute__((ext_vector_type(8)));
#define LDS_WAIT() asm volatile("s_waitcnt lgkmcnt(0)" ::: "memory")

constexpr int D = 1024, MP = 16384, MSAMP = 1024, MT = 17408, DFF = 2816, NGU = 5632, NPROJ = 3072, APROJ = 3080;
constexpr int NTHR = 512;
constexpr float KSCALE = 0.08838834764831845f;
constexpr float EPS = 1e-6f;

constexpr size_t MiB = (size_t)1 << 20;
constexpr size_t SZ_WGU = (size_t)NGU * D * 2, SZ_WD = (size_t)D * DFF * 2, SZ_WIN = (size_t)NPROJ * D * 2, SZ_SQ = (size_t)D * D * 2;
constexpr size_t WS_ROPE = 65536;
constexpr size_t WS_WGU = 1 * MiB;
constexpr size_t WS_WD = WS_WGU + 8 * SZ_WGU;
constexpr size_t WS_WIN = WS_WD + 8 * SZ_WD;
constexpr size_t WS_WOUT = WS_WIN + 2 * SZ_WIN;
constexpr size_t WS_WKV = WS_WOUT + 2 * SZ_SQ;
constexpr size_t WS_WQ = WS_WKV + (size_t)512 * D * 2;
constexpr size_t WS_WO = WS_WQ + 2 * SZ_SQ;
constexpr size_t WS_XN = WS_WO + 2 * SZ_SQ;
constexpr size_t WS_ACT = WS_XN + (size_t)MT * D * 2;
constexpr size_t WS_GATES = WS_ACT + (size_t)MT * NPROJ * 2;
constexpr size_t WS_AB = WS_GATES + (size_t)MT * 8 * 4;
constexpr size_t WS_MS = WS_AB + 8192;
constexpr size_t WS_NS = WS_MS + 8192;
constexpr size_t WS_DN = WS_NS + (size_t)8 * 129 * 128 * 4;
constexpr size_t WS_R1 = ((WS_DN + (size_t)1024 * 128 * 4 + MiB - 1) / MiB) * MiB;
constexpr size_t WS_DCT = WS_R1;
constexpr size_t WS_CTS = WS_DCT + (size_t)1024 * 32768 * 4;
constexpr size_t WS_XN2 = WS_R1;
constexpr size_t WS_QB = WS_XN2 + (size_t)MT * D * 2;
constexpr size_t WS_KVRAW = WS_QB + (size_t)MT * D * 2;
constexpr size_t WS_KB = WS_KVRAW + (size_t)MT * 512 * 4;
constexpr size_t WS_VB = WS_KB + (size_t)MP * 256 * 2;
constexpr size_t WS_SKB = WS_VB + (size_t)MP * 256 * 2;
constexpr size_t WS_SVB = WS_SKB + (size_t)128 * 136 * 256 * 2;
constexpr size_t WS_END = WS_R1 + 192 * MiB;
constexpr size_t WS_PART = WS_END;
constexpr size_t WS_TOTAL = WS_PART + 44 * MiB;
static_assert(WS_SVB + (size_t)128 * 136 * 256 * 2 <= WS_END && WS_CTS + (size_t)1024 * 32768 * 2 <= WS_END, "ws map");

constexpr size_t OFF_Y = 0;
constexpr size_t OFF_PC = (size_t)MT * D;
constexpr size_t OFF_PN = OFF_PC + 524288;
constexpr size_t OFF_PM = OFF_PN + 2048;
constexpr size_t OFF_PK = OFF_PM + 16;
constexpr size_t OFF_PV = OFF_PK + 65536;
constexpr size_t OFF_SC = OFF_PV + 65536;
constexpr size_t OFF_SN = OFF_SC + 33554432;
constexpr size_t OFF_SM = OFF_SN + 131072;
constexpr size_t OFF_SK = OFF_SM + 1024;
constexpr size_t OFF_SV = OFF_SK + 4194304;
constexpr size_t OUT_TOTAL = OFF_SV + 4194304;

constexpr int LDS_BYTES = 147456;

struct Args { const float* in[25]; float* out; unsigned char* ws; };
typedef const __attribute__((address_space(4))) Args* ArgsP;

__device__ __forceinline__ unsigned f2bf(float f) { unsigned u = __builtin_bit_cast(unsigned, f); return (u + 0x7fffu + ((u >> 16) & 1u)) >> 16; }
__device__ __forceinline__ unsigned pk2(float lo, float hi) { return f2bf(lo) | (f2bf(hi) << 16); }
__device__ __forceinline__ float bf2f(unsigned h) { return __builtin_bit_cast(float, h << 16); }
__device__ __forceinline__ float bflo(unsigned w) { return __builtin_bit_cast(float, w << 16); }
__device__ __forceinline__ float bfhi(unsigned w) { return __builtin_bit_cast(float, w & 0xffff0000u); }
__device__ __forceinline__ float wave_sum(float v) {
#pragma unroll
    for (int o = 1; o < 64; o <<= 1) v += __shfl_xor(v, o);
    return v;
}
__device__ __forceinline__ float wave_max(float v) {
#pragma unroll
    for (int o = 1; o < 64; o <<= 1) v = fmaxf(v, __shfl_xor(v, o));
    return v;
}
__device__ __forceinline__ f32x4 mfma16(bf16x8 a, bf16x8 b, f32x4 c) { return __builtin_amdgcn_mfma_f32_16x16x32_bf16(a, b, c, 0, 0, 0); }
__device__ __forceinline__ void rope_cs(int pos, double invf, float& c, float& s) {
    const double ang = (double)pos * invf;
    const double r = ang - 6.283185307179586476925 * __builtin_rint(ang * 0.15915494309189533577);
    const float rf = (float)r; c = cosf(rf); s = sinf(rf);
}
#define ROPE_INVF { 1.0, 0.1939227447486858, 0.03760603093086394, 0.007292664737217109, 0.0014142135623730955, 0.00027424817567620724, 5.318295896944988e-05, 1.0313385377212461e-05 }

__device__ __forceinline__ void cvt_item(const float* W, int ldw, int k0, int n0, bf16* dst, int K, LAS float* scr, int lane) {
#pragma unroll 4
    for (int i = 0; i < 16; ++i) { const int kk = 4 * i + (lane >> 4); const f32x4 v = *(const f32x4*)(W + (size_t)(k0 + kk) * ldw + n0 + 4 * (lane & 15));
        LAS float* s = scr + kk * 65 + 4 * (lane & 15); s[0] = v.x; s[1] = v.y; s[2] = v.z; s[3] = v.w; }
    LDS_WAIT();
    const int c = lane & 7, nn = lane >> 3;
#pragma unroll
    for (int j = 0; j < 8; ++j) { const int n = nn + 8 * j; const LAS float* s = scr + (8 * c) * 65 + n;
        u32x4 o; o.x = pk2(s[0], s[65]); o.y = pk2(s[130], s[195]); o.z = pk2(s[260], s[325]); o.w = pk2(s[390], s[455]);
        *(u32x4*)(dst + (size_t)n * K + k0 + 8 * c) = o; }
    LDS_WAIT();
}
__device__ __forceinline__ void rope_table(ArgsP a, int gw, int ngw, int lane) {
    const double invf[8] = ROPE_INVF; float* rt = (float*)(a->ws + WS_ROPE);
    for (int it = gw * 64 + lane; it < 8200 * 8; it += ngw * 64) { const int pos = it >> 3, i = it & 7; double f = invf[0];
#pragma unroll
        for (int q = 1; q < 8; ++q) f = (i == q) ? invf[q] : f;
        float c, s; rope_cs(pos, f, c, s); rt[pos * 16 + i] = c; rt[pos * 16 + 8 + i] = s; }
}
template <int L>
__device__ __forceinline__ void convert_group(ArgsP a, LAS unsigned char* lds, int wave, int lane, int gw, int ngw) {
    LAS float* scr = (LAS float*)(lds + wave * 16640);
    unsigned char* ws = a->ws;
    constexpr int I_G = 16 * 44, I_D = 44 * 16, I_FF = 2 * I_G + I_D, I_IN = 16 * 48, I_SQ = 256, I_KV = 16 * 8;
    constexpr int NITEMS = 2 * I_FF + (L < 2 ? I_IN + I_SQ : (L == 2 ? I_KV + 2 * I_SQ : 2 * I_SQ));
    for (int it = gw; it < NITEMS; it += ngw) {
        int r = it;
        if (r < 2 * I_FF) { const int li = 2 * L + r / I_FF; r %= I_FF;
            if (r < 2 * I_G) { const int up = (r >= I_G) ? 1 : 0; r -= up * I_G; const int kb = r / 44, nb = r % 44; const int n0 = nb * 64;
                const float* W = (up ? a->in[9] : a->in[8]) + (size_t)li * D * DFF;
                bf16* dst = (bf16*)(ws + WS_WGU + (size_t)li * SZ_WGU) + (size_t)((n0 >> 7) * 256 + (n0 & 127) + up * 128) * D;
                cvt_item(W, DFF, kb * 64, n0, dst, D, scr, lane);
            } else { r -= 2 * I_G; const int kb = r / 16, nb = r % 16;
                cvt_item(a->in[10] + (size_t)li * DFF * D, D, kb * 64, nb * 64, (bf16*)(ws + WS_WD + (size_t)li * SZ_WD) + (size_t)nb * 64 * DFF, DFF, scr, lane); }
            continue; }
        r -= 2 * I_FF;
        if (L < 2) {
            if (r < I_IN) { const int kb = r / 48, nb = r % 48;
                cvt_item(a->in[12] + (size_t)L * D * APROJ, APROJ, kb * 64, nb * 64, (bf16*)(ws + WS_WIN + (size_t)L * SZ_WIN) + (size_t)nb * 64 * D, D, scr, lane); continue; }
            r -= I_IN; { const int kb = r / 16, nb = r % 16;
                cvt_item(a->in[15] + (size_t)L * D * D, D, kb * 64, nb * 64, (bf16*)(ws + WS_WOUT + (size_t)L * SZ_SQ) + (size_t)nb * 64 * D, D, scr, lane); }
        } else {
            if (L == 2) { if (r < I_KV) { const int kb = r / 8, nb = r % 8;
                    cvt_item(a->in[17], 512, kb * 64, nb * 64, (bf16*)(ws + WS_WKV) + (size_t)nb * 64 * D, D, scr, lane); continue; }
                r -= I_KV; }
            const int j = L - 2;
            if (r < I_SQ) { const int kb = r / 16, nb = r % 16;
                cvt_item(a->in[19] + (size_t)j * D * D, D, kb * 64, nb * 64, (bf16*)(ws + WS_WQ + (size_t)j * SZ_SQ) + (size_t)nb * 64 * D, D, scr, lane); continue; }
            r -= I_SQ; { const int kb = r / 16, nb = r % 16;
                cvt_item(a->in[22] + (size_t)j * D * D, D, kb * 64, nb * 64, (bf16*)(ws + WS_WO + (size_t)j * SZ_SQ) + (size_t)nb * 64 * D, D, scr, lane); }
        }
    }
}

__device__ __forceinline__ void norm_phase(const float* srcP, const float* srcS, float* xcopy, const float* g1, bf16* o1, const float* g2, bf16* o2, float* fout,
                                           const LAS float* wg, const float* bgate, float* gates, const float* part, int nparts, float* xwb, int gw, int ngw, int lane) {
    f32x4 nv[4];
    if (gw < MT) { const float* xr = (gw < MP) ? srcP + (size_t)gw * D : srcS + (size_t)(gw - MP) * D;
#pragma unroll
        for (int j = 0; j < 4; ++j) nv[j] = ((const f32x4*)xr)[lane + 64 * j]; }
    for (int m = gw; m < MT; m += ngw) {
        f32x4 v[4]; float s = 0.f;
#pragma unroll
        for (int j = 0; j < 4; ++j) { v[j] = nv[j]; s += (v[j].x * v[j].x + v[j].y * v[j].y) + (v[j].z * v[j].z + v[j].w * v[j].w); }
        { const int mn = m + ngw;
            if (mn < MT) { const float* xn = (mn < MP) ? srcP + (size_t)mn * D : srcS + (size_t)(mn - MP) * D;
#pragma unroll
                for (int j = 0; j < 4; ++j) nv[j] = ((const f32x4*)xn)[lane + 64 * j]; } }
        if (part && m >= MP) {
#pragma unroll 4
            for (int p = 0; p < nparts; ++p) { const f32x4* pr = (const f32x4*)(part + (size_t)p * 1048576 + (size_t)(m - MP) * D);
#pragma unroll
                for (int j = 0; j < 4; ++j) v[j] += pr[lane + 64 * j]; }
            s = 0.f;
#pragma unroll
            for (int j = 0; j < 4; ++j) { s += (v[j].x * v[j].x + v[j].y * v[j].y) + (v[j].z * v[j].z + v[j].w * v[j].w); if (xwb) ((f32x4*)(xwb + (size_t)m * D))[lane + 64 * j] = v[j]; }
        }
        const float rstd = 1.0f / sqrtf(wave_sum(s) * (1.0f / D) + EPS);
        if (xcopy) {
#pragma unroll
            for (int j = 0; j < 4; ++j) ((f32x4*)(xcopy + (size_t)m * D))[lane + 64 * j] = v[j];
        }
        float ga[8];
#pragma unroll
        for (int q = 0; q < 8; ++q) ga[q] = 0.f;
#pragma unroll
        for (int j = 0; j < 4; ++j) { const f32x4 g = ((const f32x4*)g1)[lane + 64 * j]; const f32x4 y = v[j] * rstd * g;
            if (fout) ((f32x4*)(fout + (size_t)m * D))[lane + 64 * j] = y;
            else { u32x2 w; w.x = pk2(y.x, y.y); w.y = pk2(y.z, y.w); ((u32x2*)(o1 + (size_t)m * D))[lane + 64 * j] = w; }
            if (wg) {
#pragma unroll
                for (int e = 0; e < 4; ++e) { const int k = 4 * (lane + 64 * j) + e; const f32x4 w0 = *(const LAS f32x4*)(wg + k * 8), w1 = *(const LAS f32x4*)(wg + k * 8 + 4); const float ye = y[e];
                    ga[0] += ye * w0.x; ga[1] += ye * w0.y; ga[2] += ye * w0.z; ga[3] += ye * w0.w; ga[4] += ye * w1.x; ga[5] += ye * w1.y; ga[6] += ye * w1.z; ga[7] += ye * w1.w; }
            }
        }
        if (o2) {
#pragma unroll
            for (int j = 0; j < 4; ++j) { const f32x4 g = ((const f32x4*)g2)[lane + 64 * j]; const f32x4 y = v[j] * rstd * g;
                u32x2 w; w.x = pk2(y.x, y.y); w.y = pk2(y.z, y.w); ((u32x2*)(o2 + (size_t)m * D))[lane + 64 * j] = w; }
        }
        if (wg) {
#pragma unroll
            for (int q = 0; q < 8; ++q) ga[q] = wave_sum(ga[q]);
            float gv = ga[0];
#pragma unroll
            for (int q = 1; q < 8; ++q) gv = (lane == q) ? ga[q] : gv;
            if (lane < 8) { gv += bgate[lane]; gv = 15.0f * tanhf(gv * (1.0f / 15.0f)); if (lane >= 4) gv = -log1pf(expf(-gv)); gates[(size_t)m * 8 + lane] = gv; }
        }
    }
}

__device__ __forceinline__ void store16(bf16* bdst, float* fdst, const float (&x)[16]) {
    u32x4 w0, w1; w0.x = pk2(x[0], x[1]); w0.y = pk2(x[2], x[3]); w0.z = pk2(x[4], x[5]); w0.w = pk2(x[6], x[7]);
    w1.x = pk2(x[8], x[9]); w1.y = pk2(x[10], x[11]); w1.z = pk2(x[12], x[13]); w1.w = pk2(x[14], x[15]);
    ((u32x4*)bdst)[0] = w0; ((u32x4*)bdst)[1] = w1;
    if (fdst) {
#pragma unroll
        for (int q = 0; q < 4; ++q) ((f32x4*)fdst)[q] = (f32x4){x[4 * q], x[4 * q + 1], x[4 * q + 2], x[4 * q + 3]};
    }
}
__device__ __forceinline__ void kv_finalize(ArgsP a, int gtid, int ngt) {
    unsigned char* ws = a->ws;
    const float* kvraw = (const float*)(ws + WS_KVRAW);
    bf16* KB = (bf16*)(ws + WS_KB); bf16* VB = (bf16*)(ws + WS_VB); bf16* SKB = (bf16*)(ws + WS_SKB); bf16* SVB = (bf16*)(ws + WS_SVB);
    float* out = a->out;
    for (int it = gtid; it < MT * 32; it += ngt) {
        const int part = it & 7, kvh = (it >> 3) & 3, m = it >> 5; const int isv = part >> 2, p = part & 3;
        const float* src = kvraw + (size_t)m * 512 + isv * 256 + kvh * 64 + p * 16;
        float x[16];
#pragma unroll
        for (int q = 0; q < 4; ++q) { const f32x4 t = ((const f32x4*)src)[q]; x[4 * q] = t.x; x[4 * q + 1] = t.y; x[4 * q + 2] = t.z; x[4 * q + 3] = t.w; }
        if (part == 0) {
            const int pos = (m < MP) ? (m & 8191) : 8192 + ((m - MP) & 7);
            const float* rt = (const float*)(ws + WS_ROPE) + (size_t)pos * 16;
            const f32x4 c0 = *(const f32x4*)rt, c1 = *(const f32x4*)(rt + 4), s0 = *(const f32x4*)(rt + 8), s1 = *(const f32x4*)(rt + 12);
            const float cs[8] = {c0.x, c0.y, c0.z, c0.w, c1.x, c1.y, c1.z, c1.w}, sn[8] = {s0.x, s0.y, s0.z, s0.w, s1.x, s1.y, s1.z, s1.w};
#pragma unroll
            for (int i = 0; i < 8; ++i) { const float c = cs[i], s = sn[i]; const float x1 = x[i], x2 = x[8 + i]; x[i] = x1 * c - x2 * s; x[8 + i] = x2 * c + x1 * s; }
        }
        bf16* bdst; float* fdst = nullptr;
        if (m < MP) { const int b = m >> 13, t = m & 8191; bdst = (isv ? VB : KB) + (size_t)m * 256 + kvh * 64 + p * 16;
            if (t >= 8192 - 128) fdst = out + (isv ? OFF_PV : OFF_PK) + ((size_t)(b * 128 + t - 8064) * 4 + kvh) * 64 + p * 16; }
        else { const int ms = m - MP, b = ms >> 3, t = ms & 7; bdst = (isv ? SVB : SKB) + (size_t)(b * 136 + 128 + t) * 256 + kvh * 64 + p * 16;
            fdst = out + (isv ? OFF_SV : OFF_SK) + ((size_t)(b * 128 + 120 + t) * 4 + kvh) * 64 + p * 16; }
        store16(bdst, fdst, x);
    }
    for (int it = gtid; it < 128 * 128 * 32; it += ngt) {
        const int part = it & 7, kvh = (it >> 3) & 3, i = (it >> 5) & 127, b = it >> 12; const int isv = part >> 2, p = part & 3;
        const float* src = (isv ? a->in[6] : a->in[5]) + ((size_t)(b * 128 + i) * 4 + kvh) * 64 + p * 16;
        float x[16];
#pragma unroll
        for (int q = 0; q < 4; ++q) { const f32x4 t = ((const f32x4*)src)[q]; x[4 * q] = t.x; x[4 * q + 1] = t.y; x[4 * q + 2] = t.z; x[4 * q + 3] = t.w; }
        bf16* bdst = (isv ? SVB : SKB) + (size_t)(b * 136 + i) * 256 + kvh * 64 + p * 16;
        float* fdst = (i >= 8) ? out + (isv ? OFF_SV : OFF_SK) + ((size_t)(b * 128 + i - 8) * 4 + kvh) * 64 + p * 16 : nullptr;
        store16(bdst, fdst, x);
    }
}

template <bool SAMPLE>
__device__ __forceinline__ void attn_rowmap(int wt, int q, int b, int kvh, int j, int& head, int& grow, int& qpos) {
    if (!SAMPLE) { head = kvh * 4 + (wt >> 3); const int rib = (wt & 7) * 16 + q; grow = b * 8192 + j * 128 + rib; qpos = j * 128 + rib; }
    else { head = kvh * 4 + 2 * wt + (q >> 3); const int t = q & 7; grow = MP + b * 8 + t; qpos = 8192 + t; }
}
template <int NKT, bool SAMPLE>
__device__ __forceinline__ void attn_units(const bf16* Q, const bf16* KBp, const bf16* VBp, bf16* O, const float* sinks, const float* rope, const float* qpart, LAS unsigned char* lds, int tid, int wave, int lane, int bid, int nb) {
    constexpr int NK = 16 * NKT, KSTR = 72, VSTR = NK + 8;
    LAS bf16* Ks = (LAS bf16*)lds; LAS bf16* VT = (LAS bf16*)(lds + 256 * KSTR * 2);
    const int l15 = lane & 15, g = lane >> 4;
    for (int u = bid; u < 512; u += nb) {
        int b, kvh, j = 0, nkeys, kbase; const bf16 *ksrc, *vsrc;
        if (!SAMPLE) { kvh = u & 3; j = (u >> 2) & 63; b = u >> 8; kbase = (j - 1) * 128; nkeys = 256;
            ksrc = KBp + ((ptrdiff_t)b * 8192 + kbase) * 256 + kvh * 64; vsrc = VBp + ((ptrdiff_t)b * 8192 + kbase) * 256 + kvh * 64; }
        else { kvh = u & 3; b = u >> 2; kbase = 8192 - 128; nkeys = 136; ksrc = KBp + (ptrdiff_t)b * 136 * 256 + kvh * 64; vsrc = VBp + (ptrdiff_t)b * 136 * 256 + kvh * 64; }
        __syncthreads();
        constexpr int NST = (NK * 8 + NTHR - 1) / NTHR; u32x4 kst[NST], vst[NST];
#pragma unroll
        for (int i = 0; i < NST; ++i) { const int c = tid + i * NTHR, key = c >> 3, cc = c & 7; const bool valid = (c < NK * 8) && (key < nkeys) && (kbase + key >= 0);
            kst[i] = (u32x4){0u, 0u, 0u, 0u}; vst[i] = (u32x4){0u, 0u, 0u, 0u};
            if (valid) { kst[i] = *(const u32x4*)(ksrc + (ptrdiff_t)key * 256 + cc * 8); vst[i] = *(const u32x4*)(vsrc + (ptrdiff_t)key * 256 + cc * 8); } }
#pragma unroll
        for (int i = 0; i < NST; ++i) { const int c = tid + i * NTHR, key = c >> 3, cc = c & 7;
            if (c < NK * 8) { *(LAS u32x4*)(Ks + key * KSTR + cc * 8) = kst[i]; const u32x4 vv = vst[i];
#pragma unroll
                for (int e = 0; e < 4; ++e) { VT[(cc * 8 + 2 * e) * VSTR + key] = (bf16)(vv[e] & 0xffffu); VT[(cc * 8 + 2 * e + 1) * VSTR + key] = (bf16)(vv[e] >> 16); } } }
        __syncthreads();
        const int ntile = SAMPLE ? 2 : 32;
        for (int wt = wave; wt < ntile; wt += 8) {
            int head, grow, qpos; attn_rowmap<SAMPLE>(wt, l15, b, kvh, j, head, grow, qpos);
            u32x4 q0, q1;
            if (!SAMPLE) { const bf16* qp = Q + (size_t)grow * D + head * 64 + 8 * g; q0 = *(const u32x4*)qp; q1 = *(const u32x4*)(qp + 32); }
            else {
                const float* pp = qpart + (size_t)(grow - MP) * D + head * 64 + 8 * g; f32x4 a0 = (f32x4){0.f, 0.f, 0.f, 0.f}, a1 = a0, b0 = a0, b1 = a0;
#pragma unroll
                for (int p = 0; p < 4; ++p) { const float* q4 = pp + (size_t)p * 1048576; a0 += *(const f32x4*)q4; a1 += *(const f32x4*)(q4 + 4); b0 += *(const f32x4*)(q4 + 32); b1 += *(const f32x4*)(q4 + 36); }
                q0.x = pk2(a0.x, a0.y); q0.y = pk2(a0.z, a0.w); q0.z = pk2(a1.x, a1.y); q0.w = pk2(a1.z, a1.w);
                q1.x = pk2(b0.x, b0.y); q1.y = pk2(b0.z, b0.w); q1.z = pk2(b1.x, b1.y); q1.w = pk2(b1.z, b1.w); }
            {
                u32x4 oth; oth.x = __shfl_xor(q0.x, 16); oth.y = __shfl_xor(q0.y, 16); oth.z = __shfl_xor(q0.z, 16); oth.w = __shfl_xor(q0.w, 16);
                if (g < 2) { const float sg = (g == 0) ? -1.0f : 1.0f; u32x4 r; const float* rt = rope + (size_t)qpos * 16;
                    const f32x4 c0 = *(const f32x4*)rt, c1 = *(const f32x4*)(rt + 4), s0 = *(const f32x4*)(rt + 8), s1 = *(const f32x4*)(rt + 12);
                    const float cs[8] = {c0.x, c0.y, c0.z, c0.w, c1.x, c1.y, c1.z, c1.w}, sn[8] = {s0.x, s0.y, s0.z, s0.w, s1.x, s1.y, s1.z, s1.w};
#pragma unroll
                    for (int e = 0; e < 4; ++e) { const float a0 = bflo(q0[e]) * cs[2 * e] + sg * bflo(oth[e]) * sn[2 * e], a1 = bfhi(q0[e]) * cs[2 * e + 1] + sg * bfhi(oth[e]) * sn[2 * e + 1]; r[e] = pk2(a0, a1); }
                    q0 = r; }
            }
            const bf16x8 qf0 = __builtin_bit_cast(bf16x8, q0), qf1 = __builtin_bit_cast(bf16x8, q1);
            const int lo = max(max(qpos - 127 - kbase, -kbase), 0), hi = min(qpos - kbase, nkeys - 1); const unsigned span = (unsigned)(hi - lo);
            const int ks_lo = SAMPLE ? 0 : ((wt & 7) >> 1), ks_hi = SAMPLE ? (NKT / 2 - 1) : (((wt & 7) + 8) >> 1);
            float mx = -INFINITY;
#pragma unroll 2
            for (int kt = 2 * ks_lo; kt <= 2 * ks_hi + 1; ++kt) { f32x4 acc = (f32x4){0.f, 0.f, 0.f, 0.f};
                const LAS bf16* kp = Ks + (16 * kt + l15) * KSTR + 8 * g;
                acc = mfma16(*(const LAS bf16x8*)kp, qf0, acc); acc = mfma16(*(const LAS bf16x8*)(kp + 32), qf1, acc);
#pragma unroll
                for (int r = 0; r < 4; ++r) { const int i = 16 * kt + 4 * g + r; const bool valid = (unsigned)(i - lo) <= span; mx = fmaxf(mx, valid ? acc[r] * 0.125f : -INFINITY); } }
            mx = fmaxf(mx, __shfl_xor(mx, 16)); mx = fmaxf(mx, __shfl_xor(mx, 32));
            const float sk = sinks[head]; mx = fmaxf(mx, sk);
            float sum = 0.f;
            f32x4 oacc[4];
#pragma unroll
            for (int nt = 0; nt < 4; ++nt) oacc[nt] = (f32x4){0.f, 0.f, 0.f, 0.f};
#pragma unroll 1
            for (int ks = ks_lo; ks <= ks_hi; ++ks) { float p[2][4];
#pragma unroll
                for (int hh = 0; hh < 2; ++hh) { const int kt = 2 * ks + hh; f32x4 acc = (f32x4){0.f, 0.f, 0.f, 0.f};
                    const LAS bf16* kp = Ks + (16 * kt + l15) * KSTR + 8 * g;
                    acc = mfma16(*(const LAS bf16x8*)kp, qf0, acc); acc = mfma16(*(const LAS bf16x8*)(kp + 32), qf1, acc);
#pragma unroll
                    for (int r = 0; r < 4; ++r) { const int i = 16 * kt + 4 * g + r; const bool valid = (unsigned)(i - lo) <= span; const float pv = valid ? __expf(acc[r] * 0.125f - mx) : 0.f; p[hh][r] = pv; sum += pv; } }
                u32x4 pw; pw.x = pk2(p[0][0], p[0][1]); pw.y = pk2(p[0][2], p[0][3]); pw.z = pk2(p[1][0], p[1][1]); pw.w = pk2(p[1][2], p[1][3]);
                const bf16x8 pa = __builtin_bit_cast(bf16x8, pw);
#pragma unroll
                for (int nt = 0; nt < 4; ++nt) { const LAS bf16* vp = VT + (16 * nt + l15) * VSTR + 32 * ks + 4 * g; const u32x2 lo = *(const LAS u32x2*)vp, hi = *(const LAS u32x2*)(vp + 16);
                    const u32x4 vw = (u32x4){lo.x, lo.y, hi.x, hi.y}; oacc[nt] = mfma16(pa, __builtin_bit_cast(bf16x8, vw), oacc[nt]); } }
            sum += __shfl_xor(sum, 16); sum += __shfl_xor(sum, 32);
            const float inv = 1.0f / (sum + __expf(sk - mx));
#pragma unroll
            for (int r = 0; r < 4; ++r) { const int qq = 4 * g + r; const float ir = __shfl(inv, qq); int h2, gr2, qp2; attn_rowmap<SAMPLE>(wt, qq, b, kvh, j, h2, gr2, qp2);
                bf16* op = O + (size_t)gr2 * D + h2 * 64 + l15;
#pragma unroll
                for (int nt = 0; nt < 4; ++nt) op[16 * nt] = (bf16)f2bf(oacc[nt][r] * ir); }
        }
    }
}

__device__ __forceinline__ void mlstm_a_units(const bf16* PROJ, const float* GATES, float* DCT, float* DN, float* AB, LAS unsigned char* lds, int tid, int wave, int lane, int bid, int nb) {
    LAS bf16* KT = (LAS bf16*)lds;
    LAS bf16* AVT = (LAS bf16*)(lds + 18432);
    LAS float* av = (LAS float*)(lds + 18432 + 36864);
    const int l15 = lane & 15, g = lane >> 4;
    for (int u = bid; u < 1024; u += nb) {
        const int bh = u >> 7, c = u & 127, b = bh >> 2, h = bh & 3; const int row0 = b * 8192 + c * 64;
        __syncthreads();
        u32x4 kreg[2], vreg[4];
#pragma unroll
        for (int i = 0; i < 2; ++i) { const int ci = tid + i * NTHR, s = ci >> 4, cc = ci & 15; kreg[i] = *(const u32x4*)(PROJ + (size_t)(row0 + s) * NPROJ + 512 + h * 128 + cc * 8); }
#pragma unroll
        for (int i = 0; i < 4; ++i) { const int ci = tid + i * NTHR, s = ci >> 5, cc = ci & 31; vreg[i] = *(const u32x4*)(PROJ + (size_t)(row0 + s) * NPROJ + 1024 + h * 256 + cc * 8); }
        if (wave == 0) { const float lf = GATES[(size_t)(row0 + lane) * 8 + 4 + h], ig = GATES[(size_t)(row0 + lane) * 8 + h];
            float bs = lf;
#pragma unroll
            for (int o = 1; o < 64; o <<= 1) { const float t = __shfl_up(bs, o); if (lane >= o) bs += t; }
            const float B = __shfl(bs, 63); const float e = B - bs + ig; const float A = wave_max(e);
            av[lane] = __expf(e - A) * KSCALE; if (lane == 0) { AB[u * 2] = A; AB[u * 2 + 1] = B; } }
        __syncthreads();
#pragma unroll
        for (int i = 0; i < 2; ++i) { const int ci = tid + i * NTHR, s = ci >> 4, cc = ci & 15; const u32x4 kv = kreg[i];
#pragma unroll
            for (int e = 0; e < 4; ++e) { KT[(cc * 8 + 2 * e) * 72 + s] = (bf16)(kv[e] & 0xffffu); KT[(cc * 8 + 2 * e + 1) * 72 + s] = (bf16)(kv[e] >> 16); } }
#pragma unroll
        for (int i = 0; i < 4; ++i) { const int ci = tid + i * NTHR, s = ci >> 5, cc = ci & 31; const u32x4 vv = vreg[i]; const float as = av[s];
#pragma unroll
            for (int e = 0; e < 4; ++e) { AVT[(cc * 8 + 2 * e) * 72 + s] = (bf16)f2bf(bflo(vv[e]) * as); AVT[(cc * 8 + 2 * e + 1) * 72 + s] = (bf16)f2bf(bfhi(vv[e]) * as); } }
        __syncthreads();
        if (wave == 7) {
            u32x4 w0 = (u32x4){0u, 0u, 0u, 0u}, w1 = (u32x4){0u, 0u, 0u, 0u};
            if (l15 == 0) { const LAS float* ap0 = av + 8 * g; const LAS float* ap1 = av + 32 + 8 * g;
                w0.x = pk2(ap0[0], ap0[1]); w0.y = pk2(ap0[2], ap0[3]); w0.z = pk2(ap0[4], ap0[5]); w0.w = pk2(ap0[6], ap0[7]);
                w1.x = pk2(ap1[0], ap1[1]); w1.y = pk2(ap1[2], ap1[3]); w1.z = pk2(ap1[4], ap1[5]); w1.w = pk2(ap1[6], ap1[7]); }
            const bf16x8 a0 = __builtin_bit_cast(bf16x8, w0), a1 = __builtin_bit_cast(bf16x8, w1);
#pragma unroll
            for (int nt = 0; nt < 8; ++nt) { f32x4 acc = (f32x4){0.f, 0.f, 0.f, 0.f};
                acc = mfma16(a0, *(const LAS bf16x8*)(KT + (16 * nt + l15) * 72 + 8 * g), acc); acc = mfma16(a1, *(const LAS bf16x8*)(KT + (16 * nt + l15) * 72 + 32 + 8 * g), acc);
                if (g == 0) DN[(size_t)u * 128 + 16 * nt + l15] = acc[0]; } }
#pragma unroll
        for (int mi = 0; mi < 2; ++mi) { const int mt = 2 * wave + mi;
            const bf16x8 a0 = *(const LAS bf16x8*)(AVT + (16 * mt + l15) * 72 + 8 * g), a1 = *(const LAS bf16x8*)(AVT + (16 * mt + l15) * 72 + 32 + 8 * g);
#pragma unroll
            for (int nt = 0; nt < 8; ++nt) { f32x4 acc = (f32x4){0.f, 0.f, 0.f, 0.f};
                acc = mfma16(*(const LAS bf16x8*)(KT + (16 * nt + l15) * 72 + 8 * g), a0, acc); acc = mfma16(*(const LAS bf16x8*)(KT + (16 * nt + l15) * 72 + 32 + 8 * g), a1, acc);
                *(f32x4*)(DCT + (size_t)u * 32768 + (16 * mt + l15) * 128 + 16 * nt + 4 * g) = acc; } }
    }
}
__device__ __forceinline__ void mlstm_b(const float* DCT, const float* DN, const float* AB, bf16* CTS, float* NS, float* MSb, float* oC, float* oN, float* oM, int gtid, int ngt) {
    for (int it = gtid; it < 131072; it += ngt) { const int dp = it & 63, v = (it >> 6) & 255, bh = it >> 14;
        float m = 0.f, c0 = 0.f, c1 = 0.f;
        const float* dsrc = DCT + (size_t)bh * 128 * 32768 + v * 128 + 2 * dp; bf16* cdst = CTS + (size_t)bh * 128 * 32768 + v * 128 + 2 * dp; const float* ab = AB + bh * 256;
        for (int c = 0; c < 128; c += 16) { f32x2v d[16];
#pragma unroll
            for (int i = 0; i < 16; ++i) d[i] = *(const f32x2v*)(dsrc + (size_t)(c + i) * 32768);
#pragma unroll
            for (int i = 0; i < 16; ++i) { const float A = ab[(c + i) * 2], B = ab[(c + i) * 2 + 1]; *(unsigned*)(cdst + (size_t)(c + i) * 32768) = pk2(c0, c1);
                const float mn = fmaxf(B + m, A); const float dec = __expf(B + m - mn), inj = __expf(A - mn); c0 = dec * c0 + inj * d[i].x; c1 = dec * c1 + inj * d[i].y; m = mn; } }
        oC[((size_t)bh * 128 + 2 * dp) * 256 + v] = c0; oC[((size_t)bh * 128 + 2 * dp + 1) * 256 + v] = c1; }
    for (int it = gtid; it < 1024; it += ngt) { const int d = it & 127, bh = it >> 7; float m = 0.f, n = 0.f; const float* ab = AB + bh * 256;
        for (int c = 0; c < 128; ++c) { NS[(size_t)(bh * 129 + c) * 128 + d] = n; if (d == 0) MSb[bh * 129 + c] = m; const float A = ab[c * 2], B = ab[c * 2 + 1];
            const float mn = fmaxf(B + m, A); const float dec = __expf(B + m - mn), inj = __expf(A - mn); n = dec * n + inj * DN[(size_t)(bh * 128 + c) * 128 + d]; m = mn; }
        oN[bh * 128 + d] = n; if (d == 0) oM[bh] = m; }
}
__device__ __forceinline__ void mlstm_c_units(const bf16* PROJ, const float* GATES, const bf16* CTS, const float* NS, const float* MSb, const float* hnorm, bf16* HH, LAS unsigned char* lds, int tid, int wave, int lane, int bid, int nb) {
    LAS bf16* Qs = (LAS bf16*)lds;
    LAS bf16* Ks = (LAS bf16*)(lds + 17408);
    LAS bf16* VT = (LAS bf16*)(lds + 34816);
    LAS bf16* Ps = (LAS bf16*)(lds + 71680);
    LAS float* sc = (LAS float*)(lds + 80896);
    LAS float *s_u = sc, *s_M = sc + 64, *s_w = sc + 128, *s_e = sc + 192, *s_dens = sc + 256, *s_qn = sc + 320, *s_ss = sc + 384, *s_rden = sc + 448;
    const int l15 = lane & 15, g = lane >> 4;
    for (int u = bid; u < 1024; u += nb) {
        const int bh = u >> 7, c = u & 127, b = bh >> 2, h = bh & 3; const int row0 = b * 8192 + c * 64;
        __syncthreads();
        u32x4 qreg[2], kreg[2], vreg[4];
#pragma unroll
        for (int i = 0; i < 2; ++i) { const int ci = tid + i * NTHR, s = ci >> 4, cc = ci & 15; const bf16* rp = PROJ + (size_t)(row0 + s) * NPROJ + h * 128 + cc * 8; qreg[i] = *(const u32x4*)rp; kreg[i] = *(const u32x4*)(rp + 512); }
#pragma unroll
        for (int i = 0; i < 4; ++i) { const int ci = tid + i * NTHR, s = ci >> 5, cc = ci & 31; vreg[i] = *(const u32x4*)(PROJ + (size_t)(row0 + s) * NPROJ + 1024 + h * 256 + cc * 8); }
        if (wave == 0) { const float lf = GATES[(size_t)(row0 + lane) * 8 + 4 + h], ig = GATES[(size_t)(row0 + lane) * 8 + h];
            float bs = lf;
#pragma unroll
            for (int o = 1; o < 64; o <<= 1) { const float t = __shfl_up(bs, o); if (lane >= o) bs += t; }
            const float uu = ig - bs; float U = uu;
#pragma unroll
            for (int o = 1; o < 64; o <<= 1) { const float t = __shfl_up(U, o); if (lane >= o) U = fmaxf(U, t); }
            const float mc = MSb[bh * 129 + c]; const float Mt = fmaxf(mc, U);
            s_u[lane] = uu; s_M[lane] = Mt; s_w[lane] = __expf(mc - Mt); s_e[lane] = __expf(-(bs + Mt)); s_dens[lane] = 0.f; s_ss[lane] = 0.f; }
#pragma unroll
        for (int i = 0; i < 2; ++i) { const int ci = tid + i * NTHR, s = ci >> 4, cc = ci & 15; *(LAS u32x4*)(Qs + s * 136 + cc * 8) = qreg[i]; *(LAS u32x4*)(Ks + s * 136 + cc * 8) = kreg[i]; }
#pragma unroll
        for (int i = 0; i < 4; ++i) { const int ci = tid + i * NTHR, s = ci >> 5, cc = ci & 31; const u32x4 vv = vreg[i];
#pragma unroll
            for (int e = 0; e < 4; ++e) { VT[(cc * 8 + 2 * e) * 72 + s] = (bf16)(vv[e] & 0xffffu); VT[(cc * 8 + 2 * e + 1) * 72 + s] = (bf16)(vv[e] >> 16); } }
        u32x2 og[4][2];
#pragma unroll
        for (int mt = 0; mt < 4; ++mt)
#pragma unroll
            for (int nl = 0; nl < 2; ++nl) og[mt][nl] = *(const u32x2*)(PROJ + (size_t)(row0 + 16 * mt + l15) * NPROJ + 2048 + h * 256 + 16 * (2 * wave + nl) + 4 * g);
        __syncthreads();
#pragma unroll
        for (int ti2 = 0; ti2 < 2; ++ti2) { const int tile = 2 * wave + ti2, ti = tile >> 2, si = tile & 3;
            f32x4 acc = (f32x4){0.f, 0.f, 0.f, 0.f};
            if (si <= ti) {
#pragma unroll
                for (int ks = 0; ks < 4; ++ks) acc = mfma16(*(const LAS bf16x8*)(Qs + (16 * ti + l15) * 136 + 32 * ks + 8 * g), *(const LAS bf16x8*)(Ks + (16 * si + l15) * 136 + 32 * ks + 8 * g), acc); }
            const int s = 16 * si + l15; const float us = s_u[s];
#pragma unroll
            for (int r = 0; r < 4; ++r) { const int t = 16 * ti + 4 * g + r; float p = (s <= t) ? acc[r] * KSCALE * __expf(us - s_M[t]) : 0.f;
                Ps[t * 72 + s] = (bf16)f2bf(p);
                p += __shfl_xor(p, 1); p += __shfl_xor(p, 2); p += __shfl_xor(p, 4); p += __shfl_xor(p, 8);
                if (l15 == 0) __hip_atomic_fetch_add(s_dens + t, p, __ATOMIC_RELAXED, __HIP_MEMORY_SCOPE_WORKGROUP); } }
        {   const int t = tid >> 3, part = tid & 7; float acc = 0.f; const float* np = NS + (size_t)(bh * 129 + c) * 128 + part * 16;
#pragma unroll
            for (int dd = 0; dd < 16; ++dd) acc += bf2f(Qs[t * 136 + part * 16 + dd]) * np[dd];
            acc += __shfl_xor(acc, 1); acc += __shfl_xor(acc, 2); acc += __shfl_xor(acc, 4);
            if (part == 0) s_qn[t] = acc; }
        __syncthreads();
        if (tid < 64) { const float den = s_dens[tid] + s_w[tid] * s_qn[tid]; s_rden[tid] = 1.0f / fmaxf(fabsf(den), s_e[tid]); }
        __syncthreads();
        f32x4 a1[4][2];
#pragma unroll
        for (int nl = 0; nl < 2; ++nl) { const int nt = 2 * wave + nl; f32x4 acc[4];
#pragma unroll
            for (int mt = 0; mt < 4; ++mt) acc[mt] = (f32x4){0.f, 0.f, 0.f, 0.f};
            const bf16* cp = CTS + ((size_t)u * 256 + 16 * nt + l15) * 128 + 8 * g;
#pragma unroll
            for (int ks = 0; ks < 4; ++ks) { const bf16x8 afr = *(const bf16x8*)(cp + 32 * ks);
#pragma unroll
                for (int mt = 0; mt < 4; ++mt) acc[mt] = mfma16(afr, *(const LAS bf16x8*)(Qs + (16 * mt + l15) * 136 + 32 * ks + 8 * g), acc[mt]); }
#pragma unroll
            for (int mt = 0; mt < 4; ++mt) acc[mt] *= s_w[16 * mt + l15];
#pragma unroll
            for (int ks = 0; ks < 2; ++ks) { const bf16x8 afr = *(const LAS bf16x8*)(VT + (16 * nt + l15) * 72 + 32 * ks + 8 * g);
#pragma unroll
                for (int mt = 0; mt < 4; ++mt) acc[mt] = mfma16(afr, *(const LAS bf16x8*)(Ps + (16 * mt + l15) * 72 + 32 * ks + 8 * g), acc[mt]); }
#pragma unroll
            for (int mt = 0; mt < 4; ++mt) a1[mt][nl] = acc[mt] * s_rden[16 * mt + l15];
            asm volatile("" ::: "memory"); }
#pragma unroll
        for (int mt = 0; mt < 4; ++mt) { const int t = 16 * mt + l15; float q = 0.f;
#pragma unroll
            for (int nl = 0; nl < 2; ++nl) { const f32x4 hv = a1[mt][nl]; q += (hv[0] * hv[0] + hv[1] * hv[1]) + (hv[2] * hv[2] + hv[3] * hv[3]); }
            q += __shfl_xor(q, 16); q += __shfl_xor(q, 32);
            if (g == 0) __hip_atomic_fetch_add(s_ss + t, q, __ATOMIC_RELAXED, __HIP_MEMORY_SCOPE_WORKGROUP); }
        __syncthreads();
#pragma unroll
        for (int mt = 0; mt < 4; ++mt) { const int t = 16 * mt + l15; const float rs = 1.0f / sqrtf(s_ss[t] * (1.0f / 256.0f) + EPS);
#pragma unroll
            for (int nl = 0; nl < 2; ++nl) { const int v0 = 16 * (2 * wave + nl) + 4 * g; const u32x2 ow = og[mt][nl]; const f32x4 hn = *(const f32x4*)(hnorm + h * 256 + v0); const f32x4 hv = a1[mt][nl];
                const float o0 = bflo(ow.x), o1 = bfhi(ow.x), o2 = bflo(ow.y), o3 = bfhi(ow.y);
                u32x2 w; w.x = pk2(hv[0] * rs * hn[0] / (1.0f + __expf(-o0)), hv[1] * rs * hn[1] / (1.0f + __expf(-o1))); w.y = pk2(hv[2] * rs * hn[2] / (1.0f + __expf(-o2)), hv[3] * rs * hn[3] / (1.0f + __expf(-o3)));
                *(u32x2*)(HH + (size_t)(row0 + t) * D + h * 256 + v0) = w; } }
    }
}
__device__ __forceinline__ void mlstm_sample_units(const bf16* PROJ, const float* GATES, const float* C0, const float* n0, const float* m0, const float* hnorm, bf16* HH,
                                                   float* oC, float* oN, float* oM, LAS unsigned char* lds, int tid, int wave, int lane, int bid, int nb) {
    LAS float* q = (LAS float*)lds;
    LAS float* k = q + 1024;
    LAS float* vv = k + 1024;
    LAS float* part = vv + 2048;
    LAS float* sc = part + 16384;
    LAS float *s_S = sc, *s_u = sc + 64, *s_M = sc + 72, *s_w = sc + 80, *s_e = sc + 88, *s_a = sc + 96, *s_qn = sc + 104, *s_ss = sc + 112, *s_rden = sc + 120, *s_misc = sc + 128;
    for (int u = bid; u < 512; u += nb) {
        const int b = u >> 2, h = u & 3; const int row0 = MP + b * 8; const int bh = b * 4 + h;
        __syncthreads();
        if (tid < 128) { const int t = tid >> 4, cc = tid & 15; const u32x4 w = *(const u32x4*)(PROJ + (size_t)(row0 + t) * NPROJ + h * 128 + cc * 8);
#pragma unroll
            for (int e = 0; e < 4; ++e) { q[t * 128 + cc * 8 + 2 * e] = bflo(w[e]); q[t * 128 + cc * 8 + 2 * e + 1] = bfhi(w[e]); } }
        else if (tid < 256) { const int i = tid - 128, t = i >> 4, cc = i & 15; const u32x4 w = *(const u32x4*)(PROJ + (size_t)(row0 + t) * NPROJ + 512 + h * 128 + cc * 8);
#pragma unroll
            for (int e = 0; e < 4; ++e) { k[t * 128 + cc * 8 + 2 * e] = bflo(w[e]) * KSCALE; k[t * 128 + cc * 8 + 2 * e + 1] = bfhi(w[e]) * KSCALE; } }
        else { const int i = tid - 256, t = i >> 5, cc = i & 31; const u32x4 w = *(const u32x4*)(PROJ + (size_t)(row0 + t) * NPROJ + 1024 + h * 256 + cc * 8);
#pragma unroll
            for (int e = 0; e < 4; ++e) { vv[t * 256 + cc * 8 + 2 * e] = bflo(w[e]); vv[t * 256 + cc * 8 + 2 * e + 1] = bfhi(w[e]); } }
        if (tid == 0) { float bs[8], ig[8]; float run = 0.f;
#pragma unroll
            for (int t = 0; t < 8; ++t) { run += GATES[(size_t)(row0 + t) * 8 + 4 + h]; bs[t] = run; ig[t] = GATES[(size_t)(row0 + t) * 8 + h]; }
            const float m0v = m0[bh]; const float B = bs[7]; float A = -INFINITY;
#pragma unroll
            for (int t = 0; t < 8; ++t) A = fmaxf(A, B - bs[t] + ig[t]);
            const float mnew = fmaxf(B + m0v, A); float U = -INFINITY;
#pragma unroll
            for (int t = 0; t < 8; ++t) { const float uu = ig[t] - bs[t]; U = fmaxf(U, uu); const float Mt = fmaxf(m0v, U);
                s_u[t] = uu; s_M[t] = Mt; s_w[t] = __expf(m0v - Mt); s_e[t] = __expf(-(bs[t] + Mt)); s_a[t] = __expf(B - bs[t] + ig[t] - mnew); s_ss[t] = 0.f; }
            s_misc[0] = __expf(B + m0v - mnew); oM[bh] = mnew; }
        __syncthreads();
        const float decay = s_misc[0];
        if (tid < 64) { const int t = tid >> 3, s = tid & 7; float dot = 0.f;
            for (int d = 0; d < 128; ++d) dot += q[t * 128 + d] * k[s * 128 + d];
            s_S[t * 8 + s] = (s <= t) ? dot * __expf(s_u[s] - s_M[t]) : 0.f; }
        else if (tid < 72) { const int t = tid - 64; float dot = 0.f;
            for (int d = 0; d < 128; ++d) dot += q[t * 128 + d] * n0[(size_t)bh * 128 + d];
            s_qn[t] = dot; }
        else if (tid >= 128 && tid < 256) { const int d = tid - 128; float nn = decay * n0[(size_t)bh * 128 + d];
#pragma unroll
            for (int s = 0; s < 8; ++s) nn += s_a[s] * k[s * 128 + d];
            oN[(size_t)bh * 128 + d] = nn; }
        __syncthreads();
        if (tid < 8) { float den = s_w[tid] * s_qn[tid];
#pragma unroll
            for (int s = 0; s < 8; ++s) den += s_S[tid * 8 + s];
            s_rden[tid] = 1.0f / fmaxf(fabsf(den), s_e[tid]); }
        {
            const int v0 = 4 * (tid & 63), dg = tid >> 6; f32x4 acc[8], vr[8];
#pragma unroll
            for (int s = 0; s < 8; ++s) { acc[s] = (f32x4){0.f, 0.f, 0.f, 0.f}; vr[s] = *(const LAS f32x4*)(vv + s * 256 + v0) * s_a[s]; }
            const float* cp = C0 + ((size_t)bh * 128 + dg * 16) * 256 + v0; float* op = oC + ((size_t)bh * 128 + dg * 16) * 256 + v0;
#pragma unroll 4
            for (int dd = 0; dd < 16; ++dd) { const int d = dg * 16 + dd; const f32x4 cv = *(const f32x4*)(cp + (size_t)dd * 256); f32x4 cn = cv * decay;
#pragma unroll
                for (int s = 0; s < 8; ++s) { acc[s] += cv * q[s * 128 + d]; cn += vr[s] * k[s * 128 + d]; }
                *(f32x4*)(op + (size_t)dd * 256) = cn; }
#pragma unroll
            for (int t = 0; t < 8; ++t) *(LAS f32x4*)(part + (dg * 8 + t) * 256 + v0) = acc[t]; }
        __syncthreads();
        {   const int v = tid & 255, th = tid >> 8; float hv[4];
#pragma unroll
            for (int tt = 0; tt < 4; ++tt) { const int t = th * 4 + tt; float ps = 0.f;
#pragma unroll
                for (int dg = 0; dg < 8; ++dg) ps += part[(dg * 8 + t) * 256 + v];
                float num = s_w[t] * ps;
#pragma unroll
                for (int s = 0; s < 8; ++s) num += s_S[t * 8 + s] * vv[s * 256 + v];
                hv[tt] = num * s_rden[t]; const float qv = wave_sum(hv[tt] * hv[tt]);
                if (lane == 0) __hip_atomic_fetch_add(s_ss + t, qv, __ATOMIC_RELAXED, __HIP_MEMORY_SCOPE_WORKGROUP); }
            __syncthreads();
#pragma unroll
            for (int tt = 0; tt < 4; ++tt) { const int t = th * 4 + tt; const float rs = 1.0f / sqrtf(s_ss[t] * (1.0f / 256.0f) + EPS);
                const float o = bf2f(PROJ[(size_t)(row0 + t) * NPROJ + 2048 + h * 256 + v]);
                HH[(size_t)(row0 + t) * D + h * 256 + v] = (bf16)f2bf(hv[tt] * rs * hnorm[h * 256 + v] / (1.0f + __expf(-o))); } }
    }
}

template <class Epi>
__device__ __forceinline__ void run_gemm(LAS unsigned char* lds, const bf16* A, const bf16* Bt, int M, int N, int K, const Epi& E, int tid, int bid, int nb) {
    pg8::Gemm g{A, Bt, M, N, K, K / 64}; pg8::StaticOrder S; S.init(M, N, nb, bid);
    pg8::gemm_phase<Epi, pg8::StaticOrder, true, true>(lds, g, S, E, tid);
}
template <int NS>
__device__ __forceinline__ void run_gemm_sample_split(LAS unsigned char* lds, const bf16* A, const bf16* Bt, int K, float* PART, const float* bias, float scale, int tid, int bid, int nb) {
    const int item = bid; const bool has = item < 16 * NS; const int tile = item / NS, ks = item % NS; const int klen = K / NS;
    pg8::Gemm g{A + (size_t)ks * klen, Bt + (size_t)ks * klen, MT, D, K, klen / 64}; pg8::OneUnit S{MP / 256 + (tile >> 2), tile & 3, has};
    pg8::EpiPartial E{PART + (size_t)ks * 1048576, bias, scale, ks == 0};
    pg8::gemm_phase<pg8::EpiPartial, pg8::OneUnit, false, true>(lds, g, S, E, tid);
}

#define XB_TMO      128
#define XB_XCNT(j)  (256  + 64 * (j))
#define XB_XSUB(j)  (1280 + 64 * (j))
#define XB_XGEN(j)  (2304 + 64 * (j))
#define XB_TOP      3328
#define XB_TOPGEN   3392
#define XCD_BAR_WORDS 3456
#define XB_SPIN_CAP (1u << 18)

__device__ __forceinline__ unsigned xb_ld(unsigned* p)              { return __hip_atomic_load(p, __ATOMIC_RELAXED, __HIP_MEMORY_SCOPE_AGENT); }
__device__ __forceinline__ unsigned xb_add(unsigned* p, unsigned v) { return __hip_atomic_fetch_add(p, v, __ATOMIC_RELAXED, __HIP_MEMORY_SCOPE_AGENT); }
__device__ __forceinline__ unsigned xb_xcc_id() { return (unsigned)__builtin_amdgcn_s_getreg((3 << 11) | 20) & 0xFu; }
#define XB_SPIN(cond, bar) do { unsigned _sp = 0; while (cond) { __builtin_amdgcn_s_sleep(1); \
    if ((++_sp & 255u) == 0u) { if (xb_ld(&(bar)[XB_TMO])) break; if (_sp > XB_SPIN_CAP) { atomicAdd(&(bar)[XB_TMO], 1u); break; } } } } while (0)

struct XcdBarrier {
    unsigned* bar; unsigned x;
    volatile LAS unsigned* st;
};

__device__ __forceinline__ XcdBarrier xcd_barrier_post(unsigned* bar, volatile LAS unsigned* st) {
    XcdBarrier b; b.bar = bar; b.x = xb_xcc_id(); b.st = st;
    if (threadIdx.x == 0) (void)xb_add(&bar[XB_XCNT(b.x)], 1u);
    return b;
}
__device__ __forceinline__ void xcd_barrier_complete(unsigned* bar, unsigned x, unsigned& nloc, unsigned& nx) {
    const unsigned G = gridDim.x * gridDim.y * gridDim.z;
    unsigned sum, cnt, mine, sp = 0u;
    for (;;) {
        sum = 0u; cnt = 0u; mine = 0u;
#pragma unroll
        for (unsigned j = 0; j < 16; ++j) { const unsigned c = xb_ld(&bar[XB_XCNT(j)]); sum += c; cnt += (c > 0u) ? 1u : 0u; mine = (j == x) ? c : mine; }
        if (sum == G) break;
        __builtin_amdgcn_s_sleep(1);
        if ((++sp & 255u) == 0u) { if (xb_ld(&bar[XB_TMO])) break; if (sp > XB_SPIN_CAP) { atomicAdd(&bar[XB_TMO], 1u); break; } }
    }
    nloc = mine > 0u ? mine : 1u; nx = cnt > 0u ? cnt : 1u;
}

__device__ __forceinline__ void xcd_barrier(const XcdBarrier& b) {
    asm volatile("s_waitcnt vmcnt(0)" ::: "memory");
    __syncthreads();
    if (threadIdx.x == 0) {
        unsigned* bar = b.bar;
        __builtin_amdgcn_s_waitcnt(0);
        unsigned nloc = b.st[0], nx = b.st[1];
        if (nloc == 0u) { xcd_barrier_complete(bar, b.x, nloc, nx); b.st[0] = nloc; b.st[1] = nx; }
        const unsigned old = xb_add(&bar[XB_XSUB(b.x)], 1u);
        const unsigned gen = old / nloc;
        if (old + 1u == (gen + 1u) * nloc) {
            __builtin_amdgcn_fence(__ATOMIC_RELEASE, "agent");
            asm volatile("s_waitcnt vmcnt(0)" ::: "memory");
            const unsigned og = xb_add(&bar[XB_TOP], 1u);
            const unsigned tg = og / nx;
            if (og + 1u == (tg + 1u) * nx) xb_add(&bar[XB_TOPGEN], 1u);
            else XB_SPIN(xb_ld(&bar[XB_TOPGEN]) == tg, bar);
            __builtin_amdgcn_fence(__ATOMIC_ACQUIRE, "agent");
            xb_add(&bar[XB_XGEN(b.x)], 1u);
            asm volatile("s_waitcnt vmcnt(0)" ::: "memory");
        } else {
            XB_SPIN(xb_ld(&bar[XB_XGEN(b.x)]) == gen, bar);
            __builtin_amdgcn_fence(__ATOMIC_ACQUIRE, "agent");
            asm volatile("s_waitcnt vmcnt(0)" ::: "memory");
        }
    }
    __syncthreads();
}

#define PV int tid = threadIdx.x; int bid = blockIdx.x; asm volatile("" : "+v"(tid)); asm volatile("" : "+s"(bid)); const int nb = gridDim.x; \
    ArgsP ap = (ArgsP)__builtin_amdgcn_kernarg_segment_ptr(); asm volatile("" : "+s"(ap)); unsigned char* ws = ap->ws; float* XRES = ap->out; (void)ws; (void)XRES; \
    const int lane = tid & 63, wave = __builtin_amdgcn_readfirstlane(tid >> 6); const int gw = bid * 8 + wave, ngw = nb * 8, gtid = bid * NTHR + tid, ngt = nb * NTHR; \
    (void)lane; (void)wave; (void)gw; (void)ngw; (void)gtid; (void)ngt;
#define XBAR() do { XcdBarrier b_; b_.bar = (unsigned*)(((ArgsP)__builtin_amdgcn_kernarg_segment_ptr())->ws); b_.x = xb_xcc_id(); b_.st = (volatile LAS unsigned*)(lds + LDS_BYTES - 64); xcd_barrier(b_); } while (0)
#ifdef PROBE_SYNC
#define GSYNC() do { XBAR(); XBAR(); } while (0)
#else
#define GSYNC() XBAR()
#endif
#define REPX for (int rep_ = 0; rep_ < 2; ++rep_)
#ifdef PROBE_MA
#define DUP_MA(...) __VA_ARGS__ __VA_ARGS__
#else
#define DUP_MA(...) __VA_ARGS__
#endif
#ifdef PROBE_MB
#define DUP_MB(...) __VA_ARGS__ __VA_ARGS__
#else
#define DUP_MB(...) __VA_ARGS__
#endif
#ifdef PROBE_MC
#define DUP_MC(...) __VA_ARGS__ __VA_ARGS__
#else
#define DUP_MC(...) __VA_ARGS__
#endif
#ifdef PROBE_P0
#define REP_P0 REPX
#else
#define REP_P0
#endif
#ifdef PROBE_MLSTM
#define REP_ML REPX
#else
#define REP_ML
#endif
#ifdef PROBE_ATTN
#define REP_AT REPX
#else
#define REP_AT
#endif
#ifdef PROBE_GEMM
#define REP_GE REPX
#else
#define REP_GE
#endif
#define XN_ ((bf16*)(ws + WS_XN))
#define XN2_ ((bf16*)(ws + WS_XN2))
#define ACT_ ((bf16*)(ws + WS_ACT))
#define PROJ_ ((bf16*)(ws + WS_ACT))
#define GATES_ ((float*)(ws + WS_GATES))
#define AB_ ((float*)(ws + WS_AB))
#define MSb_ ((float*)(ws + WS_MS))
#define NS_ ((float*)(ws + WS_NS))
#define DN_ ((float*)(ws + WS_DN))
#define DCT_ ((float*)(ws + WS_DCT))
#define CTS_ ((bf16*)(ws + WS_CTS))
#define QB_ ((bf16*)(ws + WS_QB))
#define KVRAW_ ((float*)(ws + WS_KVRAW))
#define PART_ ((float*)(ws + WS_PART))

template <int l>
__device__ __forceinline__ void layer_body(LAS unsigned char* lds) {
        if (l == 2) REP_GE { PV pg8::EpiF32 E{KVRAW_, 512, ap->in[18]}; run_gemm(lds, XN2_, (const bf16*)(ws + WS_WKV), MT, 512, D, E, tid, bid, nb); }
        REP_GE { PV pg8::EpiSwiGLU E{ACT_, DFF}; run_gemm(lds, XN_, (const bf16*)(ws + WS_WGU + (size_t)(2 * l) * SZ_WGU), MT, NGU, D, E, tid, bid, nb); }
        GSYNC();
        { PV pg8::EpiResid E{XRES, D, nullptr, 0.5f}; run_gemm(lds, ACT_, (const bf16*)(ws + WS_WD + (size_t)(2 * l) * SZ_WD), MP, D, DFF, E, tid, bid, nb); }
        { PV run_gemm_sample_split<11>(lds, ACT_, (const bf16*)(ws + WS_WD + (size_t)(2 * l) * SZ_WD), DFF, PART_, nullptr, 0.5f, tid, bid, nb); }
#ifdef PROBE_DOWN
        { PV pg8::EpiResid E{XRES, D, nullptr, 0.0f}; run_gemm(lds, ACT_, (const bf16*)(ws + WS_WD + (size_t)(2 * l) * SZ_WD), MP, D, DFF, E, tid, bid, nb); }
        { PV run_gemm_sample_split<11>(lds, ACT_, (const bf16*)(ws + WS_WD + (size_t)(2 * l) * SZ_WD), DFF, PART_, nullptr, 0.5f, tid, bid, nb); }
#endif
        GSYNC();
        if (l < 2) { PV
            LAS float* wg = (LAS float*)(lds + 128);
            for (int i = tid; i < 8192; i += NTHR) wg[i] = ap->in[12][(size_t)l * D * APROJ + (size_t)(i >> 3) * APROJ + 3072 + (i & 7)];
            __syncthreads();
            norm_phase(XRES, XRES + (size_t)MP * D, nullptr, ap->in[11] + l * D, XN_, nullptr, nullptr, nullptr, wg, ap->in[13] + l * 8, GATES_, PART_, 11, XRES, gw, ngw, lane);
        } else {
            { PV norm_phase(XRES, XRES + (size_t)MP * D, nullptr, ap->in[11] + l * D, XN_, nullptr, nullptr, nullptr, nullptr, nullptr, nullptr, PART_, 11, XRES, gw, ngw, lane); }
#ifdef PROBE_NORM
        { PV norm_phase(XRES, XRES + (size_t)MP * D, nullptr, ap->in[11] + l * D, XN_, nullptr, nullptr, nullptr, nullptr, nullptr, nullptr, nullptr, 0, nullptr, gw, ngw, lane); }
#endif
            if (l == 2) { PV kv_finalize(ap, gtid, ngt); }
        }
        GSYNC();
        if (l < 2) {
            REP_GE { PV pg8::EpiBf16B E{PROJ_, NPROJ, nullptr}; run_gemm(lds, XN_, (const bf16*)(ws + WS_WIN + (size_t)l * SZ_WIN), MT, NPROJ, D, E, tid, bid, nb); }
            GSYNC();
            DUP_MA({ PV mlstm_a_units(PROJ_, GATES_, DCT_, DN_, AB_, lds, tid, wave, lane, bid, nb); })
            DUP_MA({ PV mlstm_sample_units(PROJ_, GATES_, ap->in[2] + (size_t)l * 128 * 4 * 128 * 256, ap->in[3] + (size_t)l * 128 * 4 * 128, ap->in[4] + (size_t)l * 512, ap->in[14] + l * D, XN_,
                               ap->out + OFF_SC + (size_t)l * 128 * 4 * 128 * 256, ap->out + OFF_SN + (size_t)l * 128 * 4 * 128, ap->out + OFF_SM + (size_t)l * 512, lds, tid, wave, lane, bid, nb); })
            GSYNC();
            DUP_MB({ PV mlstm_b(DCT_, DN_, AB_, CTS_, NS_, MSb_, ap->out + OFF_PC + (size_t)l * 262144, ap->out + OFF_PN + (size_t)l * 1024, ap->out + OFF_PM + (size_t)l * 8, gtid, ngt); })
            GSYNC();
            DUP_MC({ PV mlstm_c_units(PROJ_, GATES_, CTS_, NS_, MSb_, ap->in[14] + l * D, XN_, lds, tid, wave, lane, bid, nb); })
            GSYNC();
            { PV pg8::EpiResid E{XRES, D, nullptr, 1.0f}; run_gemm(lds, XN_, (const bf16*)(ws + WS_WOUT + (size_t)l * SZ_SQ), MP, D, D, E, tid, bid, nb); }
            { PV run_gemm_sample_split<4>(lds, XN_, (const bf16*)(ws + WS_WOUT + (size_t)l * SZ_SQ), D, PART_, nullptr, 1.0f, tid, bid, nb); }
        } else {
            const int j = l - 2;
            REP_GE { PV pg8::EpiBf16B E{QB_, D, ap->in[20] + j * D}; run_gemm(lds, XN_, (const bf16*)(ws + WS_WQ + (size_t)j * SZ_SQ), MP, D, D, E, tid, bid, nb); }
            { PV run_gemm_sample_split<4>(lds, XN_, (const bf16*)(ws + WS_WQ + (size_t)j * SZ_SQ), D, PART_, ap->in[20] + j * D, 1.0f, tid, bid, nb); }
            GSYNC();
            REP_AT { PV attn_units<16, false>(QB_, (const bf16*)(ws + WS_KB), (const bf16*)(ws + WS_VB), XN_, ap->in[21] + j * 16, (const float*)(ws + WS_ROPE), PART_, lds, tid, wave, lane, bid, nb); }
            REP_AT { PV attn_units<10, true>(QB_, (const bf16*)(ws + WS_SKB), (const bf16*)(ws + WS_SVB), XN_, ap->in[21] + j * 16, (const float*)(ws + WS_ROPE), PART_, lds, tid, wave, lane, bid, nb); }
            GSYNC();
            { PV pg8::EpiResid E{XRES, D, ap->in[23] + j * D, 1.0f}; run_gemm(lds, XN_, (const bf16*)(ws + WS_WO + (size_t)j * SZ_SQ), MP, D, D, E, tid, bid, nb); }
            { PV run_gemm_sample_split<4>(lds, XN_, (const bf16*)(ws + WS_WO + (size_t)j * SZ_SQ), D, PART_, ap->in[23] + j * D, 1.0f, tid, bid, nb); }
        }
        GSYNC();
        { PV norm_phase(XRES, XRES + (size_t)MP * D, nullptr, ap->in[7] + (2 * l + 1) * D, XN_, nullptr, nullptr, nullptr, nullptr, nullptr, nullptr, PART_, 4, XRES, gw, ngw, lane); }
#ifdef PROBE_NORM
        { PV norm_phase(XRES, XRES + (size_t)MP * D, nullptr, ap->in[7] + (2 * l + 1) * D, XN_, nullptr, nullptr, nullptr, nullptr, nullptr, nullptr, nullptr, 0, nullptr, gw, ngw, lane); }
#endif
        GSYNC();
        REP_GE { PV pg8::EpiSwiGLU E{ACT_, DFF}; run_gemm(lds, XN_, (const bf16*)(ws + WS_WGU + (size_t)(2 * l + 1) * SZ_WGU), MT, NGU, D, E, tid, bid, nb); }
        GSYNC();
        { PV pg8::EpiResid E{XRES, D, nullptr, 0.5f}; run_gemm(lds, ACT_, (const bf16*)(ws + WS_WD + (size_t)(2 * l + 1) * SZ_WD), MP, D, DFF, E, tid, bid, nb); }
        { PV run_gemm_sample_split<11>(lds, ACT_, (const bf16*)(ws + WS_WD + (size_t)(2 * l + 1) * SZ_WD), DFF, PART_, nullptr, 0.5f, tid, bid, nb); }
#ifdef PROBE_DOWN
        { PV pg8::EpiResid E{XRES, D, nullptr, 0.0f}; run_gemm(lds, ACT_, (const bf16*)(ws + WS_WD + (size_t)(2 * l + 1) * SZ_WD), MP, D, DFF, E, tid, bid, nb); }
        { PV run_gemm_sample_split<11>(lds, ACT_, (const bf16*)(ws + WS_WD + (size_t)(2 * l + 1) * SZ_WD), DFF, PART_, nullptr, 0.5f, tid, bid, nb); }
#endif
        GSYNC();
        if (l < 3) { PV norm_phase(XRES, XRES + (size_t)MP * D, nullptr, ap->in[7] + (2 * l + 2) * D, XN_, ap->in[16], (l == 1) ? XN2_ : nullptr, nullptr, nullptr, nullptr, nullptr, PART_, 11, XRES, gw, ngw, lane); }
#ifdef PROBE_NORM
        if (l < 3) { PV norm_phase(XRES, XRES + (size_t)MP * D, nullptr, ap->in[7] + (2 * l + 2) * D, XN_, ap->in[16], (l == 1) ? XN2_ : nullptr, nullptr, nullptr, nullptr, nullptr, nullptr, 0, nullptr, gw, ngw, lane); }
#endif
        else { PV norm_phase(XRES, XRES + (size_t)MP * D, nullptr, ap->in[24], nullptr, nullptr, nullptr, XRES, nullptr, nullptr, nullptr, PART_, 11, nullptr, gw, ngw, lane); }
        if (l < 3) GSYNC();
}

__global__ void __launch_bounds__(NTHR, 2) mk_fwd(Args a) {
    extern __shared__ __attribute__((aligned(16))) unsigned char lds_raw[];
    LAS unsigned char* lds = (LAS unsigned char*)lds_raw;
    cg::grid_group grid = cg::this_grid();
    if (a.ws == nullptr) grid.sync();
    volatile LAS unsigned* bst = (volatile LAS unsigned*)(lds + LDS_BYTES - 64);
    if (threadIdx.x < 16) bst[threadIdx.x] = 0u;
    __syncthreads();
    (void)xcd_barrier_post((unsigned*)a.ws, bst);


    REP_P0 { PV rope_table(ap, gw, ngw, lane); convert_group<0>(ap, lds, wave, lane, gw, ngw); convert_group<1>(ap, lds, wave, lane, gw, ngw); convert_group<2>(ap, lds, wave, lane, gw, ngw); convert_group<3>(ap, lds, wave, lane, gw, ngw); }
    { PV norm_phase(ap->in[0], ap->in[1], XRES, ap->in[7], XN_, nullptr, nullptr, nullptr, nullptr, nullptr, nullptr, nullptr, 0, nullptr, gw, ngw, lane); }
    GSYNC();

    layer_body<0>(lds); layer_body<1>(lds); layer_body<2>(lds); layer_body<3>(lds);
}

extern "C" void kernel_launch(void* const* d_in, const int* in_sizes, int n_in, void* d_out, int out_size, void* d_ws, size_t ws_size, hipStream_t stream) {
    static int grid = 0;
    if (grid == 0) {
        if (n_in != 25 || (size_t)out_size != OUT_TOTAL || ws_size < WS_TOTAL) {
            fprintf(stderr, "kernel_launch: unexpected shapes: n_in %d out %d ws %zu (need %zu)\n", n_in, out_size, ws_size, (size_t)WS_TOTAL); grid = -1; return; }
        int dev = 0, cus = 0, per_cu = 0;
        (void)hipGetDevice(&dev); (void)hipDeviceGetAttribute(&cus, hipDeviceAttributeMultiprocessorCount, dev);
        (void)hipFuncSetAttribute((const void*)mk_fwd, hipFuncAttributeMaxDynamicSharedMemorySize, LDS_BYTES);
        if (hipOccupancyMaxActiveBlocksPerMultiprocessor(&per_cu, (const void*)mk_fwd, NTHR, LDS_BYTES) != hipSuccess || per_cu < 1) per_cu = 1;
        (void)hipGetLastError();
        if (cus <= 0) cus = 256;
        grid = cus;
    }
    if (grid < 0) return;
    (void)hipMemsetAsync(d_ws, 0, 16384, stream);
    Args a{};
    for (int i = 0; i < 25; ++i) a.in[i] = (const float*)d_in[i];
    a.out = (float*)d_out; a.ws = (unsigned char*)d_ws;
    void* args[] = {&a};
    hipError_t e = hipLaunchCooperativeKernel((const void*)mk_fwd, dim3(grid), dim3(NTHR), args, LDS_BYTES, stream);
    if (e != hipSuccess) fprintf(stderr, "cooperative launch failed: %s (grid %d)\n", hipGetErrorString(e), grid);
}
```

```cpp
#include <hip/hip_runtime.h>
#include <hip/hip_cooperative_groups.h>
#include <cstdio>
#include <cstdint>
namespace cg = cooperative_groups;
namespace pg8 {
#define PG8_LAS __attribute__((address_space(3)))
typedef unsigned short bf16_t;
typedef short bf16x8 __attribute__((ext_vector_type(8)));
typedef float f32x4 __attribute__((ext_vector_type(4)));
typedef unsigned u32x4 __attribute__((ext_vector_type(4)));
constexpr int BM = 256, BK = 64, HALF = 128, HTB = HALF * BK * 2  , STAGE_BYTES = 8 * HTB, NXCD = 8, WGM = 8;

__host__ __device__ __forceinline__ int lds_byte(int r, int c) { const int st = (r >> 4) * 2 + (c >> 5), rr = r & 15, cc = c & 31, ob = rr * 64 + cc * 2; return st * 1024 + (ob ^ (((ob >> 9) & 1) << 5)); }
__host__ __device__ __forceinline__ void stage_rc(int b, int& R, int& C) { const int st = b / 1024, sb = b % 1024, swz = sb ^ (((sb >> 9) & 1) << 5); R = (st >> 1) * 16 + swz / 64; C = (st & 1) * 32 + (swz % 64) / 2; }
__host__ __device__ __forceinline__ int perm32(int rho) { const int n = rho >> 4, i = rho & 15; return 8 * (i >> 2) + 4 * n + (i & 3); }

struct Unit { int pm, pn; };
struct Gemm { const bf16_t* A; const bf16_t* Bt; int M, N, K, nt; };

struct StaticOrder {
    int nM, nN, nwg, G, c;
    __host__ __device__ void init(int M, int N, int G_, int c_) { nM = M / BM; nN = N / BM; nwg = nM * nN; G = G_; c = c_; }
    __host__ __device__ bool next(int i, Unit& u) const {
        const long L = (long)i * G + c; if (L >= nwg) return false;
        int wgid = (int)L; { const int q = nwg / NXCD, r = nwg % NXCD, xcd = wgid % NXCD, off = wgid / NXCD; wgid = (xcd < r ? xcd * (q + 1) : r * (q + 1) + (xcd - r) * q) + off; }
        const int nig = WGM * nN, gid = wgid / nig, fm = gid * WGM, gsz = (nM - fm) < WGM ? (nM - fm) : WGM;
        u.pm = fm + ((wgid % nig) % gsz); u.pn = (wgid % nig) / gsz; return true;
    }
    __device__ __forceinline__ void a_ready(const Unit&) const {}
    __device__ __forceinline__ void done(const Unit&) const {}
};

__device__ __forceinline__ unsigned cvt_pk_bf16(float lo, float hi) { unsigned r; asm volatile("v_cvt_pk_bf16_f32 %0, %1, %2" : "=v"(r) : "v"(lo), "v"(hi)); return r; }
typedef float f32x2 __attribute__((ext_vector_type(2)));
struct EpiBf16B {
    static constexpr bool PERM = true, AFTER_DRAIN = false;
    bf16_t* O; int ldc; const float* bias;
    __device__ __forceinline__ void operator()(const f32x4 (&acc)[2][2][4][2], const Unit& u, int wr, int wc, int fr, int fq) const {
        const int row0 = u.pm * BM + wr * 64 + fr; const int col0 = u.pn * BM + wc * 32 + 8 * fq;
        f32x4 bv[2][2];
#pragma unroll
        for (int bj = 0; bj < 2; ++bj)
#pragma unroll
            for (int n = 0; n < 2; ++n) bv[bj][n] = bias ? *(const f32x4*)(bias + col0 + bj * HALF + 4 * n) : (f32x4){0.f, 0.f, 0.f, 0.f};
#pragma unroll
        for (int ai = 0; ai < 2; ++ai)
#pragma unroll
            for (int m = 0; m < 4; ++m) { bf16_t* rowp = O + (size_t)(row0 + ai * HALF + m * 16) * ldc + col0;
#pragma unroll
                for (int bj = 0; bj < 2; ++bj) { const f32x4 v0 = acc[ai][bj][m][0] + bv[bj][0], v1 = acc[ai][bj][m][1] + bv[bj][1];
                    u32x4 w; w.x = cvt_pk_bf16(v0[0], v0[1]); w.y = cvt_pk_bf16(v0[2], v0[3]); w.z = cvt_pk_bf16(v1[0], v1[1]); w.w = cvt_pk_bf16(v1[2], v1[3]);
                    *(u32x4*)(rowp + bj * HALF) = w; } }
    }
};
__device__ __forceinline__ float silu_mul(float g, float u) { return g * u * __builtin_amdgcn_rcpf(1.0f + __builtin_amdgcn_exp2f(g * -1.4426950408889634f)); }
struct EpiSwiGLU {
    static constexpr bool PERM = true, AFTER_DRAIN = false;
    bf16_t* O; int ldc;
    __device__ __forceinline__ void operator()(const f32x4 (&acc)[2][2][4][2], const Unit& u, int wr, int wc, int fr, int fq) const {
        const int row0 = u.pm * BM + wr * 64 + fr; const int col0 = u.pn * HALF + wc * 32 + 8 * fq;
#pragma unroll
        for (int ai = 0; ai < 2; ++ai)
#pragma unroll
            for (int m = 0; m < 4; ++m) { bf16_t* rowp = O + (size_t)(row0 + ai * HALF + m * 16) * ldc + col0;
                const f32x4 g0 = acc[ai][0][m][0], g1 = acc[ai][0][m][1], u0 = acc[ai][1][m][0], u1 = acc[ai][1][m][1];
                u32x4 w; w.x = cvt_pk_bf16(silu_mul(g0[0], u0[0]), silu_mul(g0[1], u0[1])); w.y = cvt_pk_bf16(silu_mul(g0[2], u0[2]), silu_mul(g0[3], u0[3]));
                w.z = cvt_pk_bf16(silu_mul(g1[0], u1[0]), silu_mul(g1[1], u1[1])); w.w = cvt_pk_bf16(silu_mul(g1[2], u1[2]), silu_mul(g1[3], u1[3]));
                *(u32x4*)rowp = w; }
    }
};
struct EpiResid {
    static constexpr bool PERM = false, AFTER_DRAIN = false;
    float* X; int ldc; const float* bias; float scale;
    __device__ __forceinline__ void operator()(const f32x4 (&acc)[2][2][4][2], const Unit& u, int wr, int wc, int fr, int fq) const {
        const int col0 = u.pn * BM + wc * 32 + 4 * fq;
        f32x4 bv[2][2];
#pragma unroll
        for (int bj = 0; bj < 2; ++bj)
#pragma unroll
            for (int n = 0; n < 2; ++n) bv[bj][n] = bias ? *(const f32x4*)(bias + col0 + bj * HALF + n * 16) : (f32x4){0.f, 0.f, 0.f, 0.f};
#pragma unroll
        for (int ai = 0; ai < 2; ++ai) {
            float* base = X + (size_t)(u.pm * BM + ai * HALF + wr * 64 + fr) * ldc + col0;
            f32x4 old[4][2][2];
#pragma unroll
            for (int m = 0; m < 4; ++m)
#pragma unroll
                for (int bj = 0; bj < 2; ++bj)
#pragma unroll
                    for (int n = 0; n < 2; ++n) old[m][bj][n] = *(const f32x4*)(base + (size_t)(m * 16) * ldc + bj * HALF + n * 16);
#pragma unroll
            for (int m = 0; m < 4; ++m)
#pragma unroll
                for (int bj = 0; bj < 2; ++bj)
#pragma unroll
                    for (int n = 0; n < 2; ++n) *(f32x4*)(base + (size_t)(m * 16) * ldc + bj * HALF + n * 16) = old[m][bj][n] + (acc[ai][bj][m][n] + bv[bj][n]) * scale;
            asm volatile("" ::: "memory"); }
    }
};
struct EpiF32 {
    static constexpr bool PERM = false, AFTER_DRAIN = false;
    float* O; int ldc; const float* bias;
    __device__ __forceinline__ void operator()(const f32x4 (&acc)[2][2][4][2], const Unit& u, int wr, int wc, int fr, int fq) const {
        const int col0 = u.pn * BM + wc * 32 + 4 * fq;
#pragma unroll
        for (int ai = 0; ai < 2; ++ai)
#pragma unroll
            for (int m = 0; m < 4; ++m) { float* rowp = O + (size_t)(u.pm * BM + ai * HALF + wr * 64 + m * 16 + fr) * ldc + col0;
#pragma unroll
                for (int bj = 0; bj < 2; ++bj)
#pragma unroll
                    for (int n = 0; n < 2; ++n) { const f32x4 bvv = *(const f32x4*)(bias + col0 + bj * HALF + n * 16); *(f32x4*)(rowp + bj * HALF + n * 16) = acc[ai][bj][m][n] + bvv; } }
    }
};
struct OneUnit {
    int pm, pn; bool has;
    __device__ __forceinline__ bool next(int i, Unit& u) const { if (i == 0 && has) { u.pm = pm; u.pn = pn; return true; } return false; }
    __device__ __forceinline__ void a_ready(const Unit&) const {}
    __device__ __forceinline__ void done(const Unit&) const {}
};
struct EpiPartial {
    static constexpr bool PERM = false, AFTER_DRAIN = false;
    float* P; const float* bias; float scale; bool addbias;
    __device__ __forceinline__ void operator()(const f32x4 (&acc)[2][2][4][2], const Unit& u, int wr, int wc, int fr, int fq) const {
        const int col0 = u.pn * BM + wc * 32 + 4 * fq;
        f32x4 bv[2][2];
#pragma unroll
        for (int bj = 0; bj < 2; ++bj)
#pragma unroll
            for (int n = 0; n < 2; ++n) bv[bj][n] = (bias && addbias) ? *(const f32x4*)(bias + col0 + bj * HALF + n * 16) : (f32x4){0.f, 0.f, 0.f, 0.f};
#pragma unroll
        for (int ai = 0; ai < 2; ++ai)
#pragma unroll
            for (int m = 0; m < 4; ++m) { float* rowp = P + (size_t)((u.pm - 64) * BM + ai * HALF + wr * 64 + m * 16 + fr) * 1024 + col0;
#pragma unroll
                for (int bj = 0; bj < 2; ++bj)
#pragma unroll
                    for (int n = 0; n < 2; ++n) *(f32x4*)(rowp + bj * HALF + n * 16) = (acc[ai][bj][m][n] + bv[bj][n]) * scale; }
    }
};
template <class Epi, class Sched, bool ALIGN_EPI = false, bool SP2 = false>
__device__ __forceinline__ void gemm_phase(PG8_LAS unsigned char* lds, const Gemm g, const Sched& S, const Epi& E, const int tid_in) {
    const int tid = tid_in, wid = __builtin_amdgcn_readfirstlane(tid >> 6), lane = tid & 63, wr = wid >> 2, wc = wid & 3, fr = lane & 15, fq = lane >> 4;
    const int K = g.K, nt = g.nt;
    unsigned voffA[2], voffB[2];
#pragma unroll
    for (int i = 0; i < 2; ++i) { int R, C; stage_rc(tid * 16 + i * 8192, R, C); const int Rb = Epi::PERM ? ((R & ~31) + perm32(R & 31)) : R;
        voffA[i] = (unsigned)(R * K + C) * 2u; voffB[i] = (unsigned)(Rb * K + C) * 2u; }
    const size_t kstep = (size_t)(BK * 2);
    const size_t hstep = (size_t)HALF * K * 2;
    const size_t tstep = 2 * hstep;
    const unsigned ldsw = (unsigned)wid * 1024u;
    const int aoff = lds_byte(wr * 64 + fr, fq * 8), boff = lds_byte(wc * 32 + fr, fq * 8);
#define PG8_SA(b, h) (((b) * 2 + (h)) * HTB)
#define PG8_SB(b, h) ((4 + (b) * 2 + (h)) * HTB)
#define PG8_STAGE(bufoff, gbase, voff) do { _Pragma("unroll") for (int _i = 0; _i < 2; ++_i) \
        __builtin_amdgcn_global_load_lds((const unsigned*)((const char*)(gbase) + (voff)[_i]), (PG8_LAS unsigned*)(lds + (bufoff) + ldsw + _i * 8192), 16, 0, 0); } while (0)
#define PG8_LDA(dst, b, h) do { _Pragma("unroll") for (int m = 0; m < 4; ++m) _Pragma("unroll") for (int k = 0; k < 2; ++k) dst[m][k] = *(const PG8_LAS bf16x8*)(lds + PG8_SA(b, h) + aoff + m * 2048 + k * 1024); } while (0)
#define PG8_LDB(dst, b, h) do { _Pragma("unroll") for (int n = 0; n < 2; ++n) _Pragma("unroll") for (int k = 0; k < 2; ++k) dst[n][k] = *(const PG8_LAS bf16x8*)(lds + PG8_SB(b, h) + boff + n * 2048 + k * 1024); } while (0)
#define PG8_MMA(ai, bj, At, Bt) do { __builtin_amdgcn_s_setprio(1); _Pragma("unroll") for (int m = 0; m < 4; ++m) _Pragma("unroll") for (int n = 0; n < 2; ++n) _Pragma("unroll") for (int k = 0; k < 2; ++k) \
        acc[ai][bj][m][n] = __builtin_amdgcn_mfma_f32_16x16x32_bf16(Bt[n][k], At[m][k], acc[ai][bj][m][n], 0, 0, 0); __builtin_amdgcn_s_setprio(0); } while (0)
#define PG8_WAIT_V(n) asm volatile("s_waitcnt vmcnt(" #n ")" ::: "memory")
#define PG8_WAIT_L(n) asm volatile("s_waitcnt lgkmcnt(" #n ")" ::: "memory")
#define PG8_BAR __builtin_amdgcn_s_barrier()
#define PG8_SCHED __builtin_amdgcn_sched_barrier(0)
    Unit cur, nxt; int ui = 0;
    if (!S.next(0, cur)) return;
    f32x4 acc[2][2][4][2];
#pragma unroll
    for (int a = 0; a < 2; ++a)
#pragma unroll
        for (int b = 0; b < 2; ++b)
#pragma unroll
            for (int m = 0; m < 4; ++m)
#pragma unroll
                for (int n = 0; n < 2; ++n) acc[a][b][m][n] = (f32x4){0.f, 0.f, 0.f, 0.f};
    bf16x8 At[4][2], B0[2][2], B1[2][2];
    const char* cA = (const char*)g.A + (size_t)cur.pm * tstep; const char* cB = (const char*)g.Bt + (size_t)cur.pn * tstep;
    S.a_ready(cur);
    if constexpr (SP2) {
        PG8_STAGE(PG8_SB(0, 0), cB, voffB); PG8_STAGE(PG8_SB(0, 1), cB + hstep, voffB); PG8_STAGE(PG8_SA(0, 0), cA, voffA); PG8_STAGE(PG8_SA(0, 1), cA + hstep, voffA);
        if (wr == 1) PG8_BAR;
        PG8_WAIT_V(2); PG8_BAR;
        PG8_STAGE(PG8_SB(1, 0), cB + kstep, voffB); PG8_STAGE(PG8_SA(1, 0), cA + kstep, voffA); PG8_STAGE(PG8_SB(1, 1), cB + hstep + kstep, voffB);
        PG8_WAIT_V(6); PG8_BAR;
    } else {
        PG8_STAGE(PG8_SB(0, 0), cB, voffB); PG8_STAGE(PG8_SA(0, 0), cA, voffA); PG8_STAGE(PG8_SB(0, 1), cB + hstep, voffB); PG8_STAGE(PG8_SA(0, 1), cA + hstep, voffA);
        if (wr == 1) PG8_BAR;
        PG8_WAIT_V(4); PG8_BAR;
        PG8_STAGE(PG8_SB(1, 0), cB + kstep, voffB); PG8_STAGE(PG8_SA(1, 0), cA + kstep, voffA); PG8_STAGE(PG8_SB(1, 1), cB + hstep + kstep, voffB);
        PG8_WAIT_V(6); PG8_BAR;
    }
    for (;;) {
        const bool has_next = S.next(ui + 1, nxt);
        const char* nA = has_next ? (const char*)g.A + (size_t)nxt.pm * tstep : cA; const char* nB = has_next ? (const char*)g.Bt + (size_t)nxt.pn * tstep : cB;
        for (int t = 0; t < nt; t += 2) {
            const bool last = (t == nt - 2);
            const char* a1 = cA + (size_t)(t + 1) * kstep;
            const char* a2 = last ? nA : cA + (size_t)(t + 2) * kstep; const char* b2 = last ? nB : cB + (size_t)(t + 2) * kstep;
            const char* a3 = a2 + kstep; const char* b3 = b2 + kstep;
            if (last && has_next) S.a_ready(nxt);
            if constexpr (SP2) {
            PG8_LDB(B0, 0, 0); PG8_LDB(B1, 0, 1); PG8_SCHED; PG8_LDA(At, 0, 0); PG8_STAGE(PG8_SA(1, 1), a1 + hstep, voffA);
            PG8_WAIT_V(8); PG8_WAIT_L(0); PG8_BAR; PG8_MMA(0, 0, At, B0); PG8_MMA(0, 1, At, B1); PG8_BAR; PG8_SCHED;
            PG8_LDA(At, 0, 1); PG8_STAGE(PG8_SB(0, 0), b2, voffB); PG8_STAGE(PG8_SB(0, 1), b2 + hstep, voffB); PG8_STAGE(PG8_SA(0, 0), a2, voffA);
            PG8_WAIT_V(8); PG8_WAIT_L(0); PG8_BAR; PG8_MMA(1, 0, At, B0); PG8_MMA(1, 1, At, B1); PG8_BAR; PG8_SCHED;
            PG8_LDB(B0, 1, 0); PG8_LDB(B1, 1, 1); PG8_SCHED; PG8_LDA(At, 1, 0); PG8_STAGE(PG8_SA(0, 1), a2 + hstep, voffA);
            PG8_WAIT_V(8); PG8_WAIT_L(0); PG8_BAR; PG8_MMA(0, 0, At, B0); PG8_MMA(0, 1, At, B1); PG8_BAR; PG8_SCHED;
            PG8_LDA(At, 1, 1); PG8_STAGE(PG8_SB(1, 0), b3, voffB); PG8_STAGE(PG8_SB(1, 1), b3 + hstep, voffB); PG8_STAGE(PG8_SA(1, 0), a3, voffA);
            PG8_WAIT_V(8); PG8_WAIT_L(0); PG8_BAR; PG8_MMA(1, 0, At, B0); PG8_MMA(1, 1, At, B1); PG8_BAR; PG8_SCHED;
            } else {
            PG8_LDB(B0, 0, 0); PG8_SCHED; PG8_LDA(At, 0, 0); PG8_STAGE(PG8_SA(1, 1), a1 + hstep, voffA);
            PG8_WAIT_L(8); PG8_BAR; PG8_WAIT_L(0); PG8_MMA(0, 0, At, B0); PG8_BAR; PG8_SCHED;
            PG8_LDB(B1, 0, 1); PG8_STAGE(PG8_SB(0, 0), b2, voffB);
            PG8_BAR; PG8_WAIT_L(0); PG8_MMA(0, 1, At, B1); PG8_BAR;
            PG8_LDA(At, 0, 1); PG8_STAGE(PG8_SA(0, 0), a2, voffA);
            PG8_BAR; PG8_WAIT_L(0); PG8_MMA(1, 0, At, B0); PG8_BAR; PG8_SCHED;
            PG8_STAGE(PG8_SB(0, 1), b2 + hstep, voffB);
            PG8_WAIT_V(6); PG8_BAR; PG8_MMA(1, 1, At, B1); PG8_BAR;
            PG8_LDB(B0, 1, 0); PG8_SCHED; PG8_LDA(At, 1, 0); PG8_STAGE(PG8_SA(0, 1), a2 + hstep, voffA);
            PG8_WAIT_L(8); PG8_BAR; PG8_WAIT_L(0); PG8_MMA(0, 0, At, B0); PG8_BAR; PG8_SCHED;
            PG8_LDB(B1, 1, 1); PG8_STAGE(PG8_SB(1, 0), b3, voffB);
            PG8_BAR; PG8_WAIT_L(0); PG8_MMA(0, 1, At, B1); PG8_BAR;
            PG8_LDA(At, 1, 1); PG8_STAGE(PG8_SA(1, 0), a3, voffA);
            PG8_BAR; PG8_WAIT_L(0); PG8_MMA(1, 0, At, B0); PG8_BAR; PG8_SCHED;
            PG8_STAGE(PG8_SB(1, 1), b3 + hstep, voffB);
            PG8_WAIT_V(6); PG8_BAR; PG8_MMA(1, 1, At, B1); PG8_BAR;
            }
        }
        if constexpr (ALIGN_EPI) { if (wr == 0) PG8_BAR; }
        if constexpr (!Epi::AFTER_DRAIN) { E(acc, cur, wr, wc, fr, fq); S.done(cur); }
        if (!has_next) break;
#pragma unroll
        for (int a = 0; a < 2; ++a)
#pragma unroll
            for (int b = 0; b < 2; ++b)
#pragma unroll
                for (int m = 0; m < 4; ++m)
#pragma unroll
                    for (int n = 0; n < 2; ++n) acc[a][b][m][n] = (f32x4){0.f, 0.f, 0.f, 0.f};
        cur = nxt; cA = nA; cB = nB; ++ui;
        if constexpr (ALIGN_EPI) { if (wr == 1) PG8_BAR; }
    }
    PG8_WAIT_V(0);
    if constexpr (!ALIGN_EPI) { if (wr == 0) PG8_BAR; }
    PG8_BAR;
    if constexpr (Epi::AFTER_DRAIN) { E.fused(acc, cur, wr, wc, fr, fq, lds, wid, lane); S.done(cur); }
#undef PG8_SA
#undef PG8_SB
#undef PG8_STAGE
#undef PG8_LDA
#undef PG8_LDB
#undef PG8_MMA
#undef PG8_WAIT_V
#undef PG8_WAIT_L
#undef PG8_BAR
#undef PG8_SCHED
}
}

#define LAS __attribute__((address_space(3)))
typedef unsigned short bf16;
typedef unsigned u32x4 __attribute__((ext_vector_type(4)));
typedef unsigned u32x2 __attribute__((ext_vector_type(2)));
typedef float f32x4 __attribute__((ext_vector_type(4)));
typedef float f32x2v __attribute__((ext_vector_type(2)));
typedef short bf16x8 __attribute__((ext_vector_type(8)));
#define LDS_WAIT() asm volatile("s_waitcnt lgkmcnt(0)" ::: "memory")

constexpr int D = 1024, MP = 16384, MSAMP = 1024, MT = 17408, DFF = 2816, NGU = 5632, NPROJ = 3072, APROJ = 3080;
constexpr int NTHR = 512;
constexpr float KSCALE = 0.08838834764831845f;
constexpr float EPS = 1e-6f;

constexpr size_t MiB = (size_t)1 << 20;
constexpr size_t SZ_WGU = (size_t)NGU * D * 2, SZ_WD = (size_t)D * DFF * 2, SZ_WIN = (size_t)NPROJ * D * 2, SZ_SQ = (size_t)D * D * 2;
constexpr size_t WS_ROPE = 65536;
constexpr size_t WS_WGU = 1 * MiB;
constexpr size_t WS_WD = WS_WGU + 8 * SZ_WGU;
constexpr size_t WS_WIN = WS_WD + 8 * SZ_WD;
constexpr size_t WS_WOUT = WS_WIN + 2 * SZ_WIN;
constexpr size_t WS_WKV = WS_WOUT + 2 * SZ_SQ;
constexpr size_t WS_WQ = WS_WKV + (size_t)512 * D * 2;
constexpr size_t WS_WO = WS_WQ + 2 * SZ_SQ;
constexpr size_t WS_XN = WS_WO + 2 * SZ_SQ;
constexpr size_t WS_ACT = WS_XN + (size_t)MT * D * 2;
constexpr size_t WS_GATES = WS_ACT + (size_t)MT * NPROJ * 2;
constexpr size_t WS_AB = WS_GATES + (size_t)MT * 8 * 4;
constexpr size_t WS_MS = WS_AB + 8192;
constexpr size_t WS_NS = WS_MS + 8192;
constexpr size_t WS_DN = WS_NS + (size_t)8 * 129 * 128 * 4;
constexpr size_t WS_R1 = ((WS_DN + (size_t)1024 * 128 * 4 + MiB - 1) / MiB) * MiB;
constexpr size_t WS_DCT = WS_R1;
constexpr size_t WS_CTS = WS_DCT + (size_t)1024 * 32768 * 4;
constexpr size_t WS_XN2 = WS_R1;
constexpr size_t WS_QB = WS_XN2 + (size_t)MT * D * 2;
constexpr size_t WS_KVRAW = WS_QB + (size_t)MT * D * 2;
constexpr size_t WS_KB = WS_KVRAW + (size_t)MT * 512 * 4;
constexpr size_t WS_VB = WS_KB + (size_t)MP * 256 * 2;
constexpr size_t WS_SKB = WS_VB + (size_t)MP * 256 * 2;
constexpr size_t WS_SVB = WS_SKB + (size_t)128 * 136 * 256 * 2;
constexpr size_t WS_END = WS_R1 + 192 * MiB;
constexpr size_t WS_PART = WS_END;
constexpr size_t WS_TOTAL = WS_PART + 44 * MiB;
static_assert(WS_SVB + (size_t)128 * 136 * 256 * 2 <= WS_END && WS_CTS + (size_t)1024 * 32768 * 2 <= WS_END, "ws map");

constexpr size_t OFF_Y = 0;
constexpr size_t OFF_PC = (size_t)MT * D;
constexpr size_t OFF_PN = OFF_PC + 524288;
constexpr size_t OFF_PM = OFF_PN + 2048;
constexpr size_t OFF_PK = OFF_PM + 16;
constexpr size_t OFF_PV = OFF_PK + 65536;
constexpr size_t OFF_SC = OFF_PV + 65536;
constexpr size_t OFF_SN = OFF_SC + 33554432;
constexpr size_t OFF_SM = OFF_SN + 131072;
constexpr size_t OFF_SK = OFF_SM + 1024;
constexpr size_t OFF_SV = OFF_SK + 4194304;
constexpr size_t OUT_TOTAL = OFF_SV + 4194304;

constexpr int LDS_BYTES = 147456;

struct Args { const float* in[25]; float* out; unsigned char* ws; };
typedef const __attribute__((address_space(4))) Args* ArgsP;

__device__ __forceinline__ unsigned f2bf(float f) { unsigned u = __builtin_bit_cast(unsigned, f); return (u + 0x7fffu + ((u >> 16) & 1u)) >> 16; }
__device__ __forceinline__ unsigned pk2(float lo, float hi) { return f2bf(lo) | (f2bf(hi) << 16); }
__device__ __forceinline__ float bf2f(unsigned h) { return __builtin_bit_cast(float, h << 16); }
__device__ __forceinline__ float bflo(unsigned w) { return __builtin_bit_cast(float, w << 16); }
__device__ __forceinline__ float bfhi(unsigned w) { return __builtin_bit_cast(float, w & 0xffff0000u); }
__device__ __forceinline__ float wave_sum(float v) {
#pragma unroll
    for (int o = 1; o < 64; o <<= 1) v += __shfl_xor(v, o);
    return v;
}
__device__ __forceinline__ float wave_max(float v) {
#pragma unroll
    for (int o = 1; o < 64; o <<= 1) v = fmaxf(v, __shfl_xor(v, o));
    return v;
}
__device__ __forceinline__ f32x4 mfma16(bf16x8 a, bf16x8 b, f32x4 c) { return __builtin_amdgcn_mfma_f32_16x16x32_bf16(a, b, c, 0, 0, 0); }
__device__ __forceinline__ void rope_cs(int pos, double invf, float& c, float& s) {
    const double ang = (double)pos * invf;
    const double r = ang - 6.283185307179586476925 * __builtin_rint(ang * 0.15915494309189533577);
    const float rf = (float)r; c = cosf(rf); s = sinf(rf);
}
#define ROPE_INVF { 1.0, 0.1939227447486858, 0.03760603093086394, 0.007292664737217109, 0.0014142135623730955, 0.00027424817567620724, 5.318295896944988e-05, 1.0313385377212461e-05 }

__device__ __forceinline__ void cvt_item(const float* W, int ldw, int k0, int n0, bf16* dst, int K, LAS float* scr, int lane) {
#pragma unroll 4
    for (int i = 0; i < 16; ++i) { const int kk = 4 * i + (lane >> 4); const f32x4 v = *(const f32x4*)(W + (size_t)(k0 + kk) * ldw + n0 + 4 * (lane & 15));
        LAS float* s = scr + kk * 65 + 4 * (lane & 15); s[0] = v.x; s[1] = v.y; s[2] = v.z; s[3] = v.w; }
    LDS_WAIT();
    const int c = lane & 7, nn = lane >> 3;
#pragma unroll
    for (int j = 0; j < 8; ++j) { const int n = nn + 8 * j; const LAS float* s = scr + (8 * c) * 65 + n;
        u32x4 o; o.x = pk2(s[0], s[65]); o.y = pk2(s[130], s[195]); o.z = pk2(s[260], s[325]); o.w = pk2(s[390], s[455]);
        *(u32x4*)(dst + (size_t)n * K + k0 + 8 * c) = o; }
    LDS_WAIT();
}
__device__ __forceinline__ void rope_table(ArgsP a, int gw, int ngw, int lane) {
    const double invf[8] = ROPE_INVF; float* rt = (float*)(a->ws + WS_ROPE);
    for (int it = gw * 64 + lane; it < 8200 * 8; it += ngw * 64) { const int pos = it >> 3, i = it & 7; double f = invf[0];
#pragma unroll
        for (int q = 1; q < 8; ++q) f = (i == q) ? invf[q] : f;
        float c, s; rope_cs(pos, f, c, s); rt[pos * 16 + i] = c; rt[pos * 16 + 8 + i] = s; }
}
template <int L>
__device__ __forceinline__ void convert_group(ArgsP a, LAS unsigned char* lds, int wave, int lane, int gw, int ngw) {
    LAS float* scr = (LAS float*)(lds + wave * 16640);
    unsigned char* ws = a->ws;
    constexpr int I_G = 16 * 44, I_D = 44 * 16, I_FF = 2 * I_G + I_D, I_IN = 16 * 48, I_SQ = 256, I_KV = 16 * 8;
    constexpr int NITEMS = 2 * I_FF + (L < 2 ? I_IN + I_SQ : (L == 2 ? I_KV + 2 * I_SQ : 2 * I_SQ));
    for (int it = gw; it < NITEMS; it += ngw) {
        int r = it;
        if (r < 2 * I_FF) { const int li = 2 * L + r / I_FF; r %= I_FF;
            if (r < 2 * I_G) { const int up = (r >= I_G) ? 1 : 0; r -= up * I_G; const int kb = r / 44, nb = r % 44; const int n0 = nb * 64;
                const float* W = (up ? a->in[9] : a->in[8]) + (size_t)li * D * DFF;
                bf16* dst = (bf16*)(ws + WS_WGU + (size_t)li * SZ_WGU) + (size_t)((n0 >> 7) * 256 + (n0 & 127) + up * 128) * D;
                cvt_item(W, DFF, kb * 64, n0, dst, D, scr, lane);
            } else { r -= 2 * I_G; const int kb = r / 16, nb = r % 16;
                cvt_item(a->in[10] + (size_t)li * DFF * D, D, kb * 64, nb * 64, (bf16*)(ws + WS_WD + (size_t)li * SZ_WD) + (size_t)nb * 64 * DFF, DFF, scr, lane); }
            continue; }
        r -= 2 * I_FF;
        if (L < 2) {
            if (r < I_IN) { const int kb = r / 48, nb = r % 48;
                cvt_item(a->in[12] + (size_t)L * D * APROJ, APROJ, kb * 64, nb * 64, (bf16*)(ws + WS_WIN + (size_t)L * SZ_WIN) + (size_t)nb * 64 * D, D, scr, lane); continue; }
            r -= I_IN; { const int kb = r / 16, nb = r % 16;
                cvt_item(a->in[15] + (size_t)L * D * D, D, kb * 64, nb * 64, (bf16*)(ws + WS_WOUT + (size_t)L * SZ_SQ) + (size_t)nb * 64 * D, D, scr, lane); }
        } else {
            if (L == 2) { if (r < I_KV) { const int kb = r / 8, nb = r % 8;
                    cvt_item(a->in[17], 512, kb * 64, nb * 64, (bf16*)(ws + WS_WKV) + (size_t)nb * 64 * D, D, scr, lane); continue; }
                r -= I_KV; }
            const int j = L - 2;
            if (r < I_SQ) { const int kb = r / 16, nb = r % 16;
                cvt_item(a->in[19] + (size_t)j * D * D, D, kb * 64, nb * 64, (bf16*)(ws + WS_WQ + (size_t)j * SZ_SQ) + (size_t)nb * 64 * D, D, scr, lane); continue; }
            r -= I_SQ; { const int kb = r / 16, nb = r % 16;
                cvt_item(a->in[22] + (size_t)j * D * D, D, kb * 64, nb * 64, (bf16*)(ws + WS_WO + (size_t)j * SZ_SQ) + (size_t)nb * 64 * D, D, scr, lane); }
        }
    }
}

__device__ __forceinline__ void norm_phase(const float* srcP, const float* srcS, float* xcopy, const float* g1, bf16* o1, const float* g2, bf16* o2, float* fout,
                                           const LAS float* wg, const float* bgate, float* gates, const float* part, int nparts, float* xwb, int gw, int ngw, int lane) {
    f32x4 nv[4];
    if (gw < MT) { const float* xr = (gw < MP) ? srcP + (size_t)gw * D : srcS + (size_t)(gw - MP) * D;
#pragma unroll
        for (int j = 0; j < 4; ++j) nv[j] = ((const f32x4*)xr)[lane + 64 * j]; }
    for (int m = gw; m < MT; m += ngw) {
        f32x4 v[4]; float s = 0.f;
#pragma unroll
        for (int j = 0; j < 4; ++j) { v[j] = nv[j]; s += (v[j].x * v[j].x + v[j].y * v[j].y) + (v[j].z * v[j].z + v[j].w * v[j].w); }
        { const int mn = m + ngw;
            if (mn < MT) { const float* xn = (mn < MP) ? srcP + (size_t)mn * D : srcS + (size_t)(mn - MP) * D;
#pragma unroll
                for (int j = 0; j < 4; ++j) nv[j] = ((const f32x4*)xn)[lane + 64 * j]; } }
        if (part && m >= MP) {
#pragma unroll 4
            for (int p = 0; p < nparts; ++p) { const f32x4* pr = (const f32x4*)(part + (size_t)p * 1048576 + (size_t)(m - MP) * D);
#pragma unroll
                for (int j = 0; j < 4; ++j) v[j] += pr[lane + 64 * j]; }
            s = 0.f;
#pragma unroll
            for (int j = 0; j < 4; ++j) { s += (v[j].x * v[j].x + v[j].y * v[j].y) + (v[j].z * v[j].z + v[j].w * v[j].w); if (xwb) ((f32x4*)(xwb + (size_t)m * D))[lane + 64 * j] = v[j]; }
        }
        const float rstd = 1.0f / sqrtf(wave_sum(s) * (1.0f / D) + EPS);
        if (xcopy) {
#pragma unroll
            for (int j = 0; j < 4; ++j) ((f32x4*)(xcopy + (size_t)m * D))[lane + 64 * j] = v[j];
        }
        float ga[8];
#pragma unroll
        for (int q = 0; q < 8; ++q) ga[q] = 0.f;
#pragma unroll
        for (int j = 0; j < 4; ++j) { const f32x4 g = ((const f32x4*)g1)[lane + 64 * j]; const f32x4 y = v[j] * rstd * g;
            if (fout) ((f32x4*)(fout + (size_t)m * D))[lane + 64 * j] = y;
            else { u32x2 w; w.x = pk2(y.x, y.y); w.y = pk2(y.z, y.w); ((u32x2*)(o1 + (size_t)m * D))[lane + 64 * j] = w; }
            if (wg) {
#pragma unroll
                for (int e = 0; e < 4; ++e) { const int k = 4 * (lane + 64 * j) + e; const f32x4 w0 = *(const LAS f32x4*)(wg + k * 8), w1 = *(const LAS f32x4*)(wg + k * 8 + 4); const float ye = y[e];
                    ga[0] += ye * w0.x; ga[1] += ye * w0.y; ga[2] += ye * w0.z; ga[3] += ye * w0.w; ga[4] += ye * w1.x; ga[5] += ye * w1.y; ga[6] += ye * w1.z; ga[7] += ye * w1.w; }
            }
        }
        if (o2) {
#pragma unroll
            for (int j = 0; j < 4; ++j) { const f32x4 g = ((const f32x4*)g2)[lane + 64 * j]; const f32x4 y = v[j] * rstd * g;
                u32x2 w; w.x = pk2(y.x, y.y); w.y = pk2(y.z, y.w); ((u32x2*)(o2 + (size_t)m * D))[lane + 64 * j] = w; }
        }
        if (wg) {
#pragma unroll
            for (int q = 0; q < 8; ++q) ga[q] = wave_sum(ga[q]);
            float gv = ga[0];
#pragma unroll
            for (int q = 1; q < 8; ++q) gv = (lane == q) ? ga[q] : gv;
            if (lane < 8) { gv += bgate[lane]; gv = 15.0f * tanhf(gv * (1.0f / 15.0f)); if (lane >= 4) gv = -log1pf(expf(-gv)); gates[(size_t)m * 8 + lane] = gv; }
        }
    }
}

__device__ __forceinline__ void store16(bf16* bdst, float* fdst, const float (&x)[16]) {
    u32x4 w0, w1; w0.x = pk2(x[0], x[1]); w0.y = pk2(x[2], x[3]); w0.z = pk2(x[4], x[5]); w0.w = pk2(x[6], x[7]);
    w1.x = pk2(x[8], x[9]); w1.y = pk2(x[10], x[11]); w1.z = pk2(x[12], x[13]); w1.w = pk2(x[14], x[15]);
    ((u32x4*)bdst)[0] = w0; ((u32x4*)bdst)[1] = w1;
    if (fdst) {
#pragma unroll
        for (int q = 0; q < 4; ++q) ((f32x4*)fdst)[q] = (f32x4){x[4 * q], x[4 * q + 1], x[4 * q + 2], x[4 * q + 3]};
    }
}
__device__ __forceinline__ void kv_finalize(ArgsP a, int gtid, int ngt) {
    unsigned char* ws = a->ws;
    const float* kvraw = (const float*)(ws + WS_KVRAW);
    bf16* KB = (bf16*)(ws + WS_KB); bf16* VB = (bf16*)(ws + WS_VB); bf16* SKB = (bf16*)(ws + WS_SKB); bf16* SVB = (bf16*)(ws + WS_SVB);
    float* out = a->out;
    for (int it = gtid; it < MT * 32; it += ngt) {
        const int part = it & 7, kvh = (it >> 3) & 3, m = it >> 5; const int isv = part >> 2, p = part & 3;
        const float* src = kvraw + (size_t)m * 512 + isv * 256 + kvh * 64 + p * 16;
        float x[16];
#pragma unroll
        for (int q = 0; q < 4; ++q) { const f32x4 t = ((const f32x4*)src)[q]; x[4 * q] = t.x; x[4 * q + 1] = t.y; x[4 * q + 2] = t.z; x[4 * q + 3] = t.w; }
        if (part == 0) {
            const int pos = (m < MP) ? (m & 8191) : 8192 + ((m - MP) & 7);
            const float* rt = (const float*)(ws + WS_ROPE) + (size_t)pos * 16;
            const f32x4 c0 = *(const f32x4*)rt, c1 = *(const f32x4*)(rt + 4), s0 = *(const f32x4*)(rt + 8), s1 = *(const f32x4*)(rt + 12);
            const float cs[8] = {c0.x, c0.y, c0.z, c0.w, c1.x, c1.y, c1.z, c1.w}, sn[8] = {s0.x, s0.y, s0.z, s0.w, s1.x, s1.y, s1.z, s1.w};
#pragma unroll
            for (int i = 0; i < 8; ++i) { const float c = cs[i], s = sn[i]; const float x1 = x[i], x2 = x[8 + i]; x[i] = x1 * c - x2 * s; x[8 + i] = x2 * c + x1 * s; }
        }
        bf16* bdst; float* fdst = nullptr;
        if (m < MP) { const int b = m >> 13, t = m & 8191; bdst = (isv ? VB : KB) + (size_t)m * 256 + kvh * 64 + p * 16;
            if (t >= 8192 - 128) fdst = out + (isv ? OFF_PV : OFF_PK) + ((size_t)(b * 128 + t - 8064) * 4 + kvh) * 64 + p * 16; }
        else { const int ms = m - MP, b = ms >> 3, t = ms & 7; bdst = (isv ? SVB : SKB) + (size_t)(b * 136 + 128 + t) * 256 + kvh * 64 + p * 16;
            fdst = out + (isv ? OFF_SV : OFF_SK) + ((size_t)(b * 128 + 120 + t) * 4 + kvh) * 64 + p * 16; }
        store16(bdst, fdst, x);
    }
    for (int it = gtid; it < 128 * 128 * 32; it += ngt) {
        const int part = it & 7, kvh = (it >> 3) & 3, i = (it >> 5) & 127, b = it >> 12; const int isv = part >> 2, p = part & 3;
        const float* src = (isv ? a->in[6] : a->in[5]) + ((size_t)(b * 128 + i) * 4 + kvh) * 64 + p * 16;
        float x[16];
#pragma unroll
        for (int q = 0; q < 4; ++q) { const f32x4 t = ((const f32x4*)src)[q]; x[4 * q] = t.x; x[4 * q + 1] = t.y; x[4 * q + 2] = t.z; x[4 * q + 3] = t.w; }
        bf16* bdst = (isv ? SVB : SKB) + (size_t)(b * 136 + i) * 256 + kvh * 64 + p * 16;
        float* fdst = (i >= 8) ? out + (isv ? OFF_SV : OFF_SK) + ((size_t)(b * 128 + i - 8) * 4 + kvh) * 64 + p * 16 : nullptr;
        store16(bdst, fdst, x);
    }
}

template <bool SAMPLE>
__device__ __forceinline__ void attn_rowmap(int wt, int q, int b, int kvh, int j, int& head, int& grow, int& qpos) {
    if (!SAMPLE) { head = kvh * 4 + (wt >> 3); const int rib = (wt & 7) * 16 + q; grow = b * 8192 + j * 128 + rib; qpos = j * 128 + rib; }
    else { head = kvh * 4 + 2 * wt + (q >> 3); const int t = q & 7; grow = MP + b * 8 + t; qpos = 8192 + t; }
}
template <int NKT, bool SAMPLE>
__device__ __forceinline__ void attn_units(const bf16* Q, const bf16* KBp, const bf16* VBp, bf16* O, const float* sinks, const float* rope, const float* qpart, LAS unsigned char* lds, int tid, int wave, int lane, int bid, int nb) {
    constexpr int NK = 16 * NKT, KSTR = 72, VSTR = NK + 8;
    LAS bf16* Ks = (LAS bf16*)lds; LAS bf16* VT = (LAS bf16*)(lds + 256 * KSTR * 2);
    const int l15 = lane & 15, g = lane >> 4;
    for (int u = bid; u < 512; u += nb) {
        int b, kvh, j = 0, nkeys, kbase; const bf16 *ksrc, *vsrc;
        if (!SAMPLE) { kvh = u & 3; j = (u >> 2) & 63; b = u >> 8; kbase = (j - 1) * 128; nkeys = 256;
            ksrc = KBp + ((ptrdiff_t)b * 8192 + kbase) * 256 + kvh * 64; vsrc = VBp + ((ptrdiff_t)b * 8192 + kbase) * 256 + kvh * 64; }
        else { kvh = u & 3; b = u >> 2; kbase = 8192 - 128; nkeys = 136; ksrc = KBp + (ptrdiff_t)b * 136 * 256 + kvh * 64; vsrc = VBp + (ptrdiff_t)b * 136 * 256 + kvh * 64; }
        __syncthreads();
        constexpr int NST = (NK * 8 + NTHR - 1) / NTHR; u32x4 kst[NST], vst[NST];
#pragma unroll
        for (int i = 0; i < NST; ++i) { const int c = tid + i * NTHR, key = c >> 3, cc = c & 7; const bool valid = (c < NK * 8) && (key < nkeys) && (kbase + key >= 0);
            kst[i] = (u32x4){0u, 0u, 0u, 0u}; vst[i] = (u32x4){0u, 0u, 0u, 0u};
            if (valid) { kst[i] = *(const u32x4*)(ksrc + (ptrdiff_t)key * 256 + cc * 8); vst[i] = *(const u32x4*)(vsrc + (ptrdiff_t)key * 256 + cc * 8); } }
#pragma unroll
        for (int i = 0; i < NST; ++i) { const int c = tid + i * NTHR, key = c >> 3, cc = c & 7;
            if (c < NK * 8) { *(LAS u32x4*)(Ks + key * KSTR + cc * 8) = kst[i]; const u32x4 vv = vst[i];
#pragma unroll
                for (int e = 0; e < 4; ++e) { VT[(cc * 8 + 2 * e) * VSTR + key] = (bf16)(vv[e] & 0xffffu); VT[(cc * 8 + 2 * e + 1) * VSTR + key] = (bf16)(vv[e] >> 16); } } }
        __syncthreads();
        const int ntile = SAMPLE ? 2 : 32;
        for (int wt = wave; wt < ntile; wt += 8) {
            int head, grow, qpos; attn_rowmap<SAMPLE>(wt, l15, b, kvh, j, head, grow, qpos);
            u32x4 q0, q1;
            if (!SAMPLE) { const bf16* qp = Q + (size_t)grow * D + head * 64 + 8 * g; q0 = *(const u32x4*)qp; q1 = *(const u32x4*)(qp + 32); }
            else {
                const float* pp = qpart + (size_t)(grow - MP) * D + head * 64 + 8 * g; f32x4 a0 = (f32x4){0.f, 0.f, 0.f, 0.f}, a1 = a0, b0 = a0, b1 = a0;
#pragma unroll
                for (int p = 0; p < 4; ++p) { const float* q4 = pp + (size_t)p * 1048576; a0 += *(const f32x4*)q4; a1 += *(const f32x4*)(q4 + 4); b0 += *(const f32x4*)(q4 + 32); b1 += *(const f32x4*)(q4 + 36); }
                q0.x = pk2(a0.x, a0.y); q0.y = pk2(a0.z, a0.w); q0.z = pk2(a1.x, a1.y); q0.w = pk2(a1.z, a1.w);
                q1.x = pk2(b0.x, b0.y); q1.y = pk2(b0.z, b0.w); q1.z = pk2(b1.x, b1.y); q1.w = pk2(b1.z, b1.w); }
            {
                u32x4 oth; oth.x = __shfl_xor(q0.x, 16); oth.y = __shfl_xor(q0.y, 16); oth.z = __shfl_xor(q0.z, 16); oth.w = __shfl_xor(q0.w, 16);
                if (g < 2) { const float sg = (g == 0) ? -1.0f : 1.0f; u32x4 r; const float* rt = rope + (size_t)qpos * 16;
                    const f32x4 c0 = *(const f32x4*)rt, c1 = *(const f32x4*)(rt + 4), s0 = *(const f32x4*)(rt + 8), s1 = *(const f32x4*)(rt + 12);
                    const float cs[8] = {c0.x, c0.y, c0.z, c0.w, c1.x, c1.y, c1.z, c1.w}, sn[8] = {s0.x, s0.y, s0.z, s0.w, s1.x, s1.y, s1.z, s1.w};
#pragma unroll
                    for (int e = 0; e < 4; ++e) { const float a0 = bflo(q0[e]) * cs[2 * e] + sg * bflo(oth[e]) * sn[2 * e], a1 = bfhi(q0[e]) * cs[2 * e + 1] + sg * bfhi(oth[e]) * sn[2 * e + 1]; r[e] = pk2(a0, a1); }
                    q0 = r; }
            }
            const bf16x8 qf0 = __builtin_bit_cast(bf16x8, q0), qf1 = __builtin_bit_cast(bf16x8, q1);
            const int lo = max(max(qpos - 127 - kbase, -kbase), 0), hi = min(qpos - kbase, nkeys - 1); const unsigned span = (unsigned)(hi - lo);
            const int ks_lo = SAMPLE ? 0 : ((wt & 7) >> 1), ks_hi = SAMPLE ? (NKT / 2 - 1) : (((wt & 7) + 8) >> 1);
            float mx = -INFINITY;
#pragma unroll 2
            for (int kt = 2 * ks_lo; kt <= 2 * ks_hi + 1; ++kt) { f32x4 acc = (f32x4){0.f, 0.f, 0.f, 0.f};
                const LAS bf16* kp = Ks + (16 * kt + l15) * KSTR + 8 * g;
                acc = mfma16(*(const LAS bf16x8*)kp, qf0, acc); acc = mfma16(*(const LAS bf16x8*)(kp + 32), qf1, acc);
#pragma unroll
                for (int r = 0; r < 4; ++r) { const int i = 16 * kt + 4 * g + r; const bool valid = (unsigned)(i - lo) <= span; mx = fmaxf(mx, valid ? acc[r] * 0.125f : -INFINITY); } }
            mx = fmaxf(mx, __shfl_xor(mx, 16)); mx = fmaxf(mx, __shfl_xor(mx, 32));
            const float sk = sinks[head]; mx = fmaxf(mx, sk);
            float sum = 0.f;
            f32x4 oacc[4];
#pragma unroll
            for (int nt = 0; nt < 4; ++nt) oacc[nt] = (f32x4){0.f, 0.f, 0.f, 0.f};
#pragma unroll 1
            for (int ks = ks_lo; ks <= ks_hi; ++ks) { float p[2][4];
#pragma unroll
                for (int hh = 0; hh < 2; ++hh) { const int kt = 2 * ks + hh; f32x4 acc = (f32x4){0.f, 0.f, 0.f, 0.f};
                    const LAS bf16* kp = Ks + (16 * kt + l15) * KSTR + 8 * g;
                    acc = mfma16(*(const LAS bf16x8*)kp, qf0, acc); acc = mfma16(*(const LAS bf16x8*)(kp + 32), qf1, acc);
#pragma unroll
                    for (int r = 0; r < 4; ++r) { const int i = 16 * kt + 4 * g + r; const bool valid = (unsigned)(i - lo) <= span; const float pv = valid ? __expf(acc[r] * 0.125f - mx) : 0.f; p[hh][r] = pv; sum += pv; } }
                u32x4 pw; pw.x = pk2(p[0][0], p[0][1]); pw.y = pk2(p[0][2], p[0][3]); pw.z = pk2(p[1][0], p[1][1]); pw.w = pk2(p[1][2], p[1][3]);
                const bf16x8 pa = __builtin_bit_cast(bf16x8, pw);
#pragma unroll
                for (int nt = 0; nt < 4; ++nt) { const LAS bf16* vp = VT + (16 * nt + l15) * VSTR + 32 * ks + 4 * g; const u32x2 lo = *(const LAS u32x2*)vp, hi = *(const LAS u32x2*)(vp + 16);
                    const u32x4 vw = (u32x4){lo.x, lo.y, hi.x, hi.y}; oacc[nt] = mfma16(pa, __builtin_bit_cast(bf16x8, vw), oacc[nt]); } }
            sum += __shfl_xor(sum, 16); sum += __shfl_xor(sum, 32);
            const float inv = 1.0f / (sum + __expf(sk - mx));
#pragma unroll
            for (int r = 0; r < 4; ++r) { const int qq = 4 * g + r; const float ir = __shfl(inv, qq); int h2, gr2, qp2; attn_rowmap<SAMPLE>(wt, qq, b, kvh, j, h2, gr2, qp2);
                bf16* op = O + (size_t)gr2 * D + h2 * 64 + l15;
#pragma unroll
                for (int nt = 0; nt < 4; ++nt) op[16 * nt] = (bf16)f2bf(oacc[nt][r] * ir); }
        }
    }
}

__device__ __forceinline__ void mlstm_a_units(const bf16* PROJ, const float* GATES, float* DCT, float* DN, float* AB, LAS unsigned char* lds, int tid, int wave, int lane, int bid, int nb) {
    LAS bf16* KT = (LAS bf16*)lds;
    LAS bf16* AVT = (LAS bf16*)(lds + 18432);
    LAS float* av = (LAS float*)(lds + 18432 + 36864);
    const int l15 = lane & 15, g = lane >> 4;
    for (int u = bid; u < 1024; u += nb) {
        const int bh = u >> 7, c = u & 127, b = bh >> 2, h = bh & 3; const int row0 = b * 8192 + c * 64;
        __syncthreads();
        u32x4 kreg[2], vreg[4];
#pragma unroll
        for (int i = 0; i < 2; ++i) { const int ci = tid + i * NTHR, s = ci >> 4, cc = ci & 15; kreg[i] = *(const u32x4*)(PROJ + (size_t)(row0 + s) * NPROJ + 512 + h * 128 + cc * 8); }
#pragma unroll
        for (int i = 0; i < 4; ++i) { const int ci = tid + i * NTHR, s = ci >> 5, cc = ci & 31; vreg[i] = *(const u32x4*)(PROJ + (size_t)(row0 + s) * NPROJ + 1024 + h * 256 + cc * 8); }
        if (wave == 0) { const float lf = GATES[(size_t)(row0 + lane) * 8 + 4 + h], ig = GATES[(size_t)(row0 + lane) * 8 + h];
            float bs = lf;
#pragma unroll
            for (int o = 1; o < 64; o <<= 1) { const float t = __shfl_up(bs, o); if (lane >= o) bs += t; }
            const float B = __shfl(bs, 63); const float e = B - bs + ig; const float A = wave_max(e);
            av[lane] = __expf(e - A) * KSCALE; if (lane == 0) { AB[u * 2] = A; AB[u * 2 + 1] = B; } }
        __syncthreads();
#pragma unroll
        for (int i = 0; i < 2; ++i) { const int ci = tid + i * NTHR, s = ci >> 4, cc = ci & 15; const u32x4 kv = kreg[i];
#pragma unroll
            for (int e = 0; e < 4; ++e) { KT[(cc * 8 + 2 * e) * 72 + s] = (bf16)(kv[e] & 0xffffu); KT[(cc * 8 + 2 * e + 1) * 72 + s] = (bf16)(kv[e] >> 16); } }
#pragma unroll
        for (int i = 0; i < 4; ++i) { const int ci = tid + i * NTHR, s = ci >> 5, cc = ci & 31; const u32x4 vv = vreg[i]; const float as = av[s];
#pragma unroll
            for (int e = 0; e < 4; ++e) { AVT[(cc * 8 + 2 * e) * 72 + s] = (bf16)f2bf(bflo(vv[e]) * as); AVT[(cc * 8 + 2 * e + 1) * 72 + s] = (bf16)f2bf(bfhi(vv[e]) * as); } }
        __syncthreads();
        if (wave == 7) {
            u32x4 w0 = (u32x4){0u, 0u, 0u, 0u}, w1 = (u32x4){0u, 0u, 0u, 0u};
            if (l15 == 0) { const LAS float* ap0 = av + 8 * g; const LAS float* ap1 = av + 32 + 8 * g;
                w0.x = pk2(ap0[0], ap0[1]); w0.y = pk2(ap0[2], ap0[3]); w0.z = pk2(ap0[4], ap0[5]); w0.w = pk2(ap0[6], ap0[7]);
                w1.x = pk2(ap1[0], ap1[1]); w1.y = pk2(ap1[2], ap1[3]); w1.z = pk2(ap1[4], ap1[5]); w1.w = pk2(ap1[6], ap1[7]); }
            const bf16x8 a0 = __builtin_bit_cast(bf16x8, w0), a1 = __builtin_bit_cast(bf16x8, w1);
#pragma unroll
            for (int nt = 0; nt < 8; ++nt) { f32x4 acc = (f32x4){0.f, 0.f, 0.f, 0.f};
                acc = mfma16(a0, *(const LAS bf16x8*)(KT + (16 * nt + l15) * 72 + 8 * g), acc); acc = mfma16(a1, *(const LAS bf16x8*)(KT + (16 * nt + l15) * 72 + 32 + 8 * g), acc);
                if (g == 0) DN[(size_t)u * 128 + 16 * nt + l15] = acc[0]; } }
#pragma unroll
        for (int mi = 0; mi < 2; ++mi) { const int mt = 2 * wave + mi;
            const bf16x8 a0 = *(const LAS bf16x8*)(AVT + (16 * mt + l15) * 72 + 8 * g), a1 = *(const LAS bf16x8*)(AVT + (16 * mt + l15) * 72 + 32 + 8 * g);
#pragma unroll
            for (int nt = 0; nt < 8; ++nt) { f32x4 acc = (f32x4){0.f, 0.f, 0.f, 0.f};
                acc = mfma16(*(const LAS bf16x8*)(KT + (16 * nt + l15) * 72 + 8 * g), a0, acc); acc = mfma16(*(const LAS bf16x8*)(KT + (16 * nt + l15) * 72 + 32 + 8 * g), a1, acc);
                *(f32x4*)(DCT + (size_t)u * 32768 + (16 * mt + l15) * 128 + 16 * nt + 4 * g) = acc; } }
    }
}
__device__ __forceinline__ void mlstm_b(const float* DCT, const float* DN, const float* AB, bf16* CTS, float* NS, float* MSb, float* oC, float* oN, float* oM, int gtid, int ngt) {
    for (int it = gtid; it < 131072; it += ngt) { const int dp = it & 63, v = (it >> 6) & 255, bh = it >> 14;
        float m = 0.f, c0 = 0.f, c1 = 0.f;
        const float* dsrc = DCT + (size_t)bh * 128 * 32768 + v * 128 + 2 * dp; bf16* cdst = CTS + (size_t)bh * 128 * 32768 + v * 128 + 2 * dp; const float* ab = AB + bh * 256;
        for (int c = 0; c < 128; c += 16) { f32x2v d[16];
#pragma unroll
            for (int i = 0; i < 16; ++i) d[i] = *(const f32x2v*)(dsrc + (size_t)(c + i) * 32768);
#pragma unroll
            for (int i = 0; i < 16; ++i) { const float A = ab[(c + i) * 2], B = ab[(c + i) * 2 + 1]; *(unsigned*)(cdst + (size_t)(c + i) * 32768) = pk2(c0, c1);
                const float mn = fmaxf(B + m, A); const float dec = __expf(B + m - mn), inj = __expf(A - mn); c0 = dec * c0 + inj * d[i].x; c1 = dec * c1 + inj * d[i].y; m = mn; } }
        oC[((size_t)bh * 128 + 2 * dp) * 256 + v] = c0; oC[((size_t)bh * 128 + 2 * dp + 1) * 256 + v] = c1; }
    for (int it = gtid; it < 1024; it += ngt) { const int d = it & 127, bh = it >> 7; float m = 0.f, n = 0.f; const float* ab = AB + bh * 256;
        for (int c = 0; c < 128; ++c) { NS[(size_t)(bh * 129 + c) * 128 + d] = n; if (d == 0) MSb[bh * 129 + c] = m; const float A = ab[c * 2], B = ab[c * 2 + 1];
            const float mn = fmaxf(B + m, A); const float dec = __expf(B + m - mn), inj = __expf(A - mn); n = dec * n + inj * DN[(size_t)(bh * 128 + c) * 128 + d]; m = mn; }
        oN[bh * 128 + d] = n; if (d == 0) oM[bh] = m; }
}
__device__ __forceinline__ void mlstm_c_units(const bf16* PROJ, const float* GATES, const bf16* CTS, const float* NS, const float* MSb, const float* hnorm, bf16* HH, LAS unsigned char* lds, int tid, int wave, int lane, int bid, int nb) {
    LAS bf16* Qs = (LAS bf16*)lds;
    LAS bf16* Ks = (LAS bf16*)(lds + 17408);
    LAS bf16* VT = (LAS bf16*)(lds + 34816);
    LAS bf16* Ps = (LAS bf16*)(lds + 71680);
    LAS float* sc = (LAS float*)(lds + 80896);
    LAS float *s_u = sc, *s_M = sc + 64, *s_w = sc + 128, *s_e = sc + 192, *s_dens = sc + 256, *s_qn = sc + 320, *s_ss = sc + 384, *s_rden = sc + 448;
    const int l15 = lane & 15, g = lane >> 4;
    for (int u = bid; u < 1024; u += nb) {
        const int bh = u >> 7, c = u & 127, b = bh >> 2, h = bh & 3; const int row0 = b * 8192 + c * 64;
        __syncthreads();
        u32x4 qreg[2], kreg[2], vreg[4];
#pragma unroll
        for (int i = 0; i < 2; ++i) { const int ci = tid + i * NTHR, s = ci >> 4, cc = ci & 15; const bf16* rp = PROJ + (size_t)(row0 + s) * NPROJ + h * 128 + cc * 8; qreg[i] = *(const u32x4*)rp; kreg[i] = *(const u32x4*)(rp + 512); }
#pragma unroll
        for (int i = 0; i < 4; ++i) { const int ci = tid + i * NTHR, s = ci >> 5, cc = ci & 31; vreg[i] = *(const u32x4*)(PROJ + (size_t)(row0 + s) * NPROJ + 1024 + h * 256 + cc * 8); }
        if (wave == 0) { const float lf = GATES[(size_t)(row0 + lane) * 8 + 4 + h], ig = GATES[(size_t)(row0 + lane) * 8 + h];
            float bs = lf;
#pragma unroll
            for (int o = 1; o < 64; o <<= 1) { const float t = __shfl_up(bs, o); if (lane >= o) bs += t; }
            const float uu = ig - bs; float U = uu;
#pragma unroll
            for (int o = 1; o < 64; o <<= 1) { const float t = __shfl_up(U, o); if (lane >= o) U = fmaxf(U, t); }
            const float mc = MSb[bh * 129 + c]; const float Mt = fmaxf(mc, U);
            s_u[lane] = uu; s_M[lane] = Mt; s_w[lane] = __expf(mc - Mt); s_e[lane] = __expf(-(bs + Mt)); s_dens[lane] = 0.f; s_ss[lane] = 0.f; }
#pragma unroll
        for (int i = 0; i < 2; ++i) { const int ci = tid + i * NTHR, s = ci >> 4, cc = ci & 15; *(LAS u32x4*)(Qs + s * 136 + cc * 8) = qreg[i]; *(LAS u32x4*)(Ks + s * 136 + cc * 8) = kreg[i]; }
#pragma unroll
        for (int i = 0; i < 4; ++i) { const int ci = tid + i * NTHR, s = ci >> 5, cc = ci & 31; const u32x4 vv = vreg[i];
#pragma unroll
            for (int e = 0; e < 4; ++e) { VT[(cc * 8 + 2 * e) * 72 + s] = (bf16)(vv[e] & 0xffffu); VT[(cc * 8 + 2 * e + 1) * 72 + s] = (bf16)(vv[e] >> 16); } }
        u32x2 og[4][2];
#pragma unroll
        for (int mt = 0; mt < 4; ++mt)
#pragma unroll
            for (int nl = 0; nl < 2; ++nl) og[mt][nl] = *(const u32x2*)(PROJ + (size_t)(row0 + 16 * mt + l15) * NPROJ + 2048 + h * 256 + 16 * (2 * wave + nl) + 4 * g);
        __syncthreads();
#pragma unroll
        for (int ti2 = 0; ti2 < 2; ++ti2) { const int tile = 2 * wave + ti2, ti = tile >> 2, si = tile & 3;
            f32x4 acc = (f32x4){0.f, 0.f, 0.f, 0.f};
            if (si <= ti) {
#pragma unroll
                for (int ks = 0; ks < 4; ++ks) acc = mfma16(*(const LAS bf16x8*)(Qs + (16 * ti + l15) * 136 + 32 * ks + 8 * g), *(const LAS bf16x8*)(Ks + (16 * si + l15) * 136 + 32 * ks + 8 * g), acc); }
            const int s = 16 * si + l15; const float us = s_u[s];
#pragma unroll
            for (int r = 0; r < 4; ++r) { const int t = 16 * ti + 4 * g + r; float p = (s <= t) ? acc[r] * KSCALE * __expf(us - s_M[t]) : 0.f;
                Ps[t * 72 + s] = (bf16)f2bf(p);
                p += __shfl_xor(p, 1); p += __shfl_xor(p, 2); p += __shfl_xor(p, 4); p += __shfl_xor(p, 8);
                if (l15 == 0) __hip_atomic_fetch_add(s_dens + t, p, __ATOMIC_RELAXED, __HIP_MEMORY_SCOPE_WORKGROUP); } }
        {   const int t = tid >> 3, part = tid & 7; float acc = 0.f; const float* np = NS + (size_t)(bh * 129 + c) * 128 + part * 16;
#pragma unroll
            for (int dd = 0; dd < 16; ++dd) acc += bf2f(Qs[t * 136 + part * 16 + dd]) * np[dd];
            acc += __shfl_xor(acc, 1); acc += __shfl_xor(acc, 2); acc += __shfl_xor(acc, 4);
            if (part == 0) s_qn[t] = acc; }
        __syncthreads();
        if (tid < 64) { const float den = s_dens[tid] + s_w[tid] * s_qn[tid]; s_rden[tid] = 1.0f / fmaxf(fabsf(den), s_e[tid]); }
        __syncthreads();
        f32x4 a1[4][2];
#pragma unroll
        for (int nl = 0; nl < 2; ++nl) { const int nt = 2 * wave + nl; f32x4 acc[4];
#pragma unroll
            for (int mt = 0; mt < 4; ++mt) acc[mt] = (f32x4){0.f, 0.f, 0.f, 0.f};
            const bf16* cp = CTS + ((size_t)u * 256 + 16 * nt + l15) * 128 + 8 * g;
#pragma unroll
            for (int ks = 0; ks < 4; ++ks) { const bf16x8 afr = *(const bf16x8*)(cp + 32 * ks);
#pragma unroll
                for (int mt = 0; mt < 4; ++mt) acc[mt] = mfma16(afr, *(const LAS bf16x8*)(Qs + (16 * mt + l15) * 136 + 32 * ks + 8 * g), acc[mt]); }
#pragma unroll
            for (int mt = 0; mt < 4; ++mt) acc[mt] *= s_w[16 * mt + l15];
#pragma unroll
            for (int ks = 0; ks < 2; ++ks) { const bf16x8 afr = *(const LAS bf16x8*)(VT + (16 * nt + l15) * 72 + 32 * ks + 8 * g);
#pragma unroll
                for (int mt = 0; mt < 4; ++mt) acc[mt] = mfma16(afr, *(const LAS bf16x8*)(Ps + (16 * mt + l15) * 72 + 32 * ks + 8 * g), acc[mt]); }
#pragma unroll
            for (int mt = 0; mt < 4; ++mt) a1[mt][nl] = acc[mt] * s_rden[16 * mt + l15];
            asm volatile("" ::: "memory"); }
#pragma unroll
        for (int mt = 0; mt < 4; ++mt) { const int t = 16 * mt + l15; float q = 0.f;
#pragma unroll
            for (int nl = 0; nl < 2; ++nl) { const f32x4 hv = a1[mt][nl]; q += (hv[0] * hv[0] + hv[1] * hv[1]) + (hv[2] * hv[2] + hv[3] * hv[3]); }
            q += __shfl_xor(q, 16); q += __shfl_xor(q, 32);
            if (g == 0) __hip_atomic_fetch_add(s_ss + t, q, __ATOMIC_RELAXED, __HIP_MEMORY_SCOPE_WORKGROUP); }
        __syncthreads();
#pragma unroll
        for (int mt = 0; mt < 4; ++mt) { const int t = 16 * mt + l15; const float rs = 1.0f / sqrtf(s_ss[t] * (1.0f / 256.0f) + EPS);
#pragma unroll
            for (int nl = 0; nl < 2; ++nl) { const int v0 = 16 * (2 * wave + nl) + 4 * g; const u32x2 ow = og[mt][nl]; const f32x4 hn = *(const f32x4*)(hnorm + h * 256 + v0); const f32x4 hv = a1[mt][nl];
                const float o0 = bflo(ow.x), o1 = bfhi(ow.x), o2 = bflo(ow.y), o3 = bfhi(ow.y);
                u32x2 w; w.x = pk2(hv[0] * rs * hn[0] / (1.0f + __expf(-o0)), hv[1] * rs * hn[1] / (1.0f + __expf(-o1))); w.y = pk2(hv[2] * rs * hn[2] / (1.0f + __expf(-o2)), hv[3] * rs * hn[3] / (1.0f + __expf(-o3)));
                *(u32x2*)(HH + (size_t)(row0 + t) * D + h * 256 + v0) = w; } }
    }
}
__device__ __forceinline__ void mlstm_sample_units(const bf16* PROJ, const float* GATES, const float* C0, const float* n0, const float* m0, const float* hnorm, bf16* HH,
                                                   float* oC, float* oN, float* oM, LAS unsigned char* lds, int tid, int wave, int lane, int bid, int nb) {
    LAS float* q = (LAS float*)lds;
    LAS float* k = q + 1024;
    LAS float* vv = k + 1024;
    LAS float* part = vv + 2048;
    LAS float* sc = part + 16384;
    LAS float *s_S = sc, *s_u = sc + 64, *s_M = sc + 72, *s_w = sc + 80, *s_e = sc + 88, *s_a = sc + 96, *s_qn = sc + 104, *s_ss = sc + 112, *s_rden = sc + 120, *s_misc = sc + 128;
    for (int u = bid; u < 512; u += nb) {
        const int b = u >> 2, h = u & 3; const int row0 = MP + b * 8; const int bh = b * 4 + h;
        __syncthreads();
        if (tid < 128) { const int t = tid >> 4, cc = tid & 15; const u32x4 w = *(const u32x4*)(PROJ + (size_t)(row0 + t) * NPROJ + h * 128 + cc * 8);
#pragma unroll
            for (int e = 0; e < 4; ++e) { q[t * 128 + cc * 8 + 2 * e] = bflo(w[e]); q[t * 128 + cc * 8 + 2 * e + 1] = bfhi(w[e]); } }
        else if (tid < 256) { const int i = tid - 128, t = i >> 4, cc = i & 15; const u32x4 w = *(const u32x4*)(PROJ + (size_t)(row0 + t) * NPROJ + 512 + h * 128 + cc * 8);
#pragma unroll
            for (int e = 0; e < 4; ++e) { k[t * 128 + cc * 8 + 2 * e] = bflo(w[e]) * KSCALE; k[t * 128 + cc * 8 + 2 * e + 1] = bfhi(w[e]) * KSCALE; } }
        else { const int i = tid - 256, t = i >> 5, cc = i & 31; const u32x4 w = *(const u32x4*)(PROJ + (size_t)(row0 + t) * NPROJ + 1024 + h * 256 + cc * 8);
#pragma unroll
            for (int e = 0; e < 4; ++e) { vv[t * 256 + cc * 8 + 2 * e] = bflo(w[e]); vv[t * 256 + cc * 8 + 2 * e + 1] = bfhi(w[e]); } }
        if (tid == 0) { float bs[8], ig[8]; float run = 0.f;
#pragma unroll
            for (int t = 0; t < 8; ++t) { run += GATES[(size_t)(row0 + t) * 8 + 4 + h]; bs[t] = run; ig[t] = GATES[(size_t)(row0 + t) * 8 + h]; }
            const float m0v = m0[bh]; const float B = bs[7]; float A = -INFINITY;
#pragma unroll
            for (int t = 0; t < 8; ++t) A = fmaxf(A, B - bs[t] + ig[t]);
            const float mnew = fmaxf(B + m0v, A); float U = -INFINITY;
#pragma unroll
            for (int t = 0; t < 8; ++t) { const float uu = ig[t] - bs[t]; U = fmaxf(U, uu); const float Mt = fmaxf(m0v, U);
                s_u[t] = uu; s_M[t] = Mt; s_w[t] = __expf(m0v - Mt); s_e[t] = __expf(-(bs[t] + Mt)); s_a[t] = __expf(B - bs[t] + ig[t] - mnew); s_ss[t] = 0.f; }
            s_misc[0] = __expf(B + m0v - mnew); oM[bh] = mnew; }
        __syncthreads();
        const float decay = s_misc[0];
        if (tid < 64) { const int t = tid >> 3, s = tid & 7; float dot = 0.f;
            for (int d = 0; d < 128; ++d) dot += q[t * 128 + d] * k[s * 128 + d];
            s_S[t * 8 + s] = (s <= t) ? dot * __expf(s_u[s] - s_M[t]) : 0.f; }
        else if (tid < 72) { const int t = tid - 64; float dot = 0.f;
            for (int d = 0; d < 128; ++d) dot += q[t * 128 + d] * n0[(size_t)bh * 128 + d];
            s_qn[t] = dot; }
        else if (tid >= 128 && tid < 256) { const int d = tid - 128; float nn = decay * n0[(size_t)bh * 128 + d];
#pragma unroll
            for (int s = 0; s < 8; ++s) nn += s_a[s] * k[s * 128 + d];
            oN[(size_t)bh * 128 + d] = nn; }
        __syncthreads();
        if (tid < 8) { float den = s_w[tid] * s_qn[tid];
#pragma unroll
            for (int s = 0; s < 8; ++s) den += s_S[tid * 8 + s];
            s_rden[tid] = 1.0f / fmaxf(fabsf(den), s_e[tid]); }
        {
            const int v0 = 4 * (tid & 63), dg = tid >> 6; f32x4 acc[8], vr[8];
#pragma unroll
            for (int s = 0; s < 8; ++s) { acc[s] = (f32x4){0.f, 0.f, 0.f, 0.f}; vr[s] = *(const LAS f32x4*)(vv + s * 256 + v0) * s_a[s]; }
            const float* cp = C0 + ((size_t)bh * 128 + dg * 16) * 256 + v0; float* op = oC + ((size_t)bh * 128 + dg * 16) * 256 + v0;
#pragma unroll 4
            for (int dd = 0; dd < 16; ++dd) { const int d = dg * 16 + dd; const f32x4 cv = *(const f32x4*)(cp + (size_t)dd * 256); f32x4 cn = cv * decay;
#pragma unroll
                for (int s = 0; s < 8; ++s) { acc[s] += cv * q[s * 128 + d]; cn += vr[s] * k[s * 128 + d]; }
                *(f32x4*)(op + (size_t)dd * 256) = cn; }
#pragma unroll
            for (int t = 0; t < 8; ++t) *(LAS f32x4*)(part + (dg * 8 + t) * 256 + v0) = acc[t]; }
        __syncthreads();
        {   const int v = tid & 255, th = tid >> 8; float hv[4];
#pragma unroll
            for (int tt = 0; tt < 4; ++tt) { const int t = th * 4 + tt; float ps = 0.f;
#pragma unroll
                for (int dg = 0; dg < 8; ++dg) ps += part[(dg * 8 + t) * 256 + v];
                float num = s_w[t] * ps;
#pragma unroll
                for (int s = 0; s < 8; ++s) num += s_S[t * 8 + s] * vv[s * 256 + v];
                hv[tt] = num * s_rden[t]; const float qv = wave_sum(hv[tt] * hv[tt]);
                if (lane == 0) __hip_atomic_fetch_add(s_ss + t, qv, __ATOMIC_RELAXED, __HIP_MEMORY_SCOPE_WORKGROUP); }
            __syncthreads();
#pragma unroll
            for (int tt = 0; tt < 4; ++tt) { const int t = th * 4 + tt; const float rs = 1.0f / sqrtf(s_ss[t] * (1.0f / 256.0f) + EPS);
                const float o = bf2f(PROJ[(size_t)(row0 + t) * NPROJ + 2048 + h * 256 + v]);
                HH[(size_t)(row0 + t) * D + h * 256 + v] = (bf16)f2bf(hv[tt] * rs * hnorm[h * 256 + v] / (1.0f + __expf(-o))); } }
    }
}

template <class Epi>
__device__ __forceinline__ void run_gemm(LAS unsigned char* lds, const bf16* A, const bf16* Bt, int M, int N, int K, const Epi& E, int tid, int bid, int nb) {
    pg8::Gemm g{A, Bt, M, N, K, K / 64}; pg8::StaticOrder S; S.init(M, N, nb, bid);
    pg8::gemm_phase<Epi, pg8::StaticOrder, false, true>(lds, g, S, E, tid);
}
template <int NS>
__device__ __forceinline__ void run_gemm_sample_split(LAS unsigned char* lds, const bf16* A, const bf16* Bt, int K, float* PART, const float* bias, float scale, int tid, int bid, int nb) {
    const int item = bid; const bool has = item < 16 * NS; const int tile = item / NS, ks = item % NS; const int klen = K / NS;
    pg8::Gemm g{A + (size_t)ks * klen, Bt + (size_t)ks * klen, MT, D, K, klen / 64}; pg8::OneUnit S{MP / 256 + (tile >> 2), tile & 3, has};
    pg8::EpiPartial E{PART + (size_t)ks * 1048576, bias, scale, ks == 0};
    pg8::gemm_phase<pg8::EpiPartial, pg8::OneUnit, false, true>(lds, g, S, E, tid);
}

#define XB_TMO      128
#define XB_XCNT(j)  (256  + 64 * (j))
#define XB_XSUB(j)  (1280 + 64 * (j))
#define XB_XGEN(j)  (2304 + 64 * (j))
#define XB_TOP      3328
#define XB_TOPGEN   3392
#define XCD_BAR_WORDS 3456
#define XB_SPIN_CAP (1u << 18)

__device__ __forceinline__ unsigned xb_ld(unsigned* p)              { return __hip_atomic_load(p, __ATOMIC_RELAXED, __HIP_MEMORY_SCOPE_AGENT); }
__device__ __forceinline__ unsigned xb_add(unsigned* p, unsigned v) { return __hip_atomic_fetch_add(p, v, __ATOMIC_RELAXED, __HIP_MEMORY_SCOPE_AGENT); }
__device__ __forceinline__ unsigned xb_xcc_id() { return (unsigned)__builtin_amdgcn_s_getreg((3 << 11) | 20) & 0xFu; }
#define XB_SPIN(cond, bar) do { unsigned _sp = 0; while (cond) { __builtin_amdgcn_s_sleep(1); \
    if ((++_sp & 255u) == 0u) { if (xb_ld(&(bar)[XB_TMO])) break; if (_sp > XB_SPIN_CAP) { atomicAdd(&(bar)[XB_TMO], 1u); break; } } } } while (0)

struct XcdBarrier {
    unsigned* bar; unsigned x;
    volatile LAS unsigned* st;
};

__device__ __forceinline__ XcdBarrier xcd_barrier_post(unsigned* bar, volatile LAS unsigned* st) {
    XcdBarrier b; b.bar = bar; b.x = xb_xcc_id(); b.st = st;
    if (threadIdx.x == 0) (void)xb_add(&bar[XB_XCNT(b.x)], 1u);
    return b;
}
__device__ __forceinline__ void xcd_barrier_complete(unsigned* bar, unsigned x, unsigned& nloc, unsigned& nx) {
    const unsigned G = gridDim.x * gridDim.y * gridDim.z;
    unsigned sum, cnt, mine, sp = 0u;
    for (;;) {
        sum = 0u; cnt = 0u; mine = 0u;
#pragma unroll
        for (unsigned j = 0; j < 16; ++j) { const unsigned c = xb_ld(&bar[XB_XCNT(j)]); sum += c; cnt += (c > 0u) ? 1u : 0u; mine = (j == x) ? c : mine; }
        if (sum == G) break;
        __builtin_amdgcn_s_sleep(1);
        if ((++sp & 255u) == 0u) { if (xb_ld(&bar[XB_TMO])) break; if (sp > XB_SPIN_CAP) { atomicAdd(&bar[XB_TMO], 1u); break; } }
    }
    nloc = mine > 0u ? mine : 1u; nx = cnt > 0u ? cnt : 1u;
}

__device__ __forceinline__ void xcd_barrier(const XcdBarrier& b) {
    asm volatile("s_waitcnt vmcnt(0)" ::: "memory");
    __syncthreads();
    if (threadIdx.x == 0) {
        unsigned* bar = b.bar;
        __builtin_amdgcn_s_waitcnt(0);
        unsigned nloc = b.st[0], nx = b.st[1];
        if (nloc == 0u) { xcd_barrier_complete(bar, b.x, nloc, nx); b.st[0] = nloc; b.st[1] = nx; }
        const unsigned old = xb_add(&bar[XB_XSUB(b.x)], 1u);
        const unsigned gen = old / nloc;
        if (old + 1u == (gen + 1u) * nloc) {
            __builtin_amdgcn_fence(__ATOMIC_RELEASE, "agent");
            asm volatile("s_waitcnt vmcnt(0)" ::: "memory");
            const unsigned og = xb_add(&bar[XB_TOP], 1u);
            const unsigned tg = og / nx;
            if (og + 1u == (tg + 1u) * nx) xb_add(&bar[XB_TOPGEN], 1u);
            else XB_SPIN(xb_ld(&bar[XB_TOPGEN]) == tg, bar);
            __builtin_amdgcn_fence(__ATOMIC_ACQUIRE, "agent");
            xb_add(&bar[XB_XGEN(b.x)], 1u);
            asm volatile("s_waitcnt vmcnt(0)" ::: "memory");
        } else {
            XB_SPIN(xb_ld(&bar[XB_XGEN(b.x)]) == gen, bar);
            __builtin_amdgcn_fence(__ATOMIC_ACQUIRE, "agent");
            asm volatile("s_waitcnt vmcnt(0)" ::: "memory");
        }
    }
    __syncthreads();
}

#define PV int tid = threadIdx.x; int bid = blockIdx.x; asm volatile("" : "+v"(tid)); asm volatile("" : "+s"(bid)); const int nb = gridDim.x; \
    ArgsP ap = (ArgsP)__builtin_amdgcn_kernarg_segment_ptr(); asm volatile("" : "+s"(ap)); unsigned char* ws = ap->ws; float* XRES = ap->out; (void)ws; (void)XRES; \
    const int lane = tid & 63, wave = __builtin_amdgcn_readfirstlane(tid >> 6); const int gw = bid * 8 + wave, ngw = nb * 8, gtid = bid * NTHR + tid, ngt = nb * NTHR; \
    (void)lane; (void)wave; (void)gw; (void)ngw; (void)gtid; (void)ngt;
#define XBAR() do { XcdBarrier b_; b_.bar = (unsigned*)(((ArgsP)__builtin_amdgcn_kernarg_segment_ptr())->ws); b_.x = xb_xcc_id(); b_.st = (volatile LAS unsigned*)(lds + LDS_BYTES - 64); xcd_barrier(b_); } while (0)
#ifdef PROBE_SYNC
#define GSYNC() do { XBAR(); XBAR(); } while (0)
#else
#define GSYNC() XBAR()
#endif
#define REPX for (int rep_ = 0; rep_ < 2; ++rep_)
#ifdef PROBE_MA
#define DUP_MA(...) __VA_ARGS__ __VA_ARGS__
#else
#define DUP_MA(...) __VA_ARGS__
#endif
#ifdef PROBE_MB
#define DUP_MB(...) __VA_ARGS__ __VA_ARGS__
#else
#define DUP_MB(...) __VA_ARGS__
#endif
#ifdef PROBE_MC
#define DUP_MC(...) __VA_ARGS__ __VA_ARGS__
#else
#define DUP_MC(...) __VA_ARGS__
#endif
#ifdef PROBE_P0
#define REP_P0 REPX
#else
#define REP_P0
#endif
#ifdef PROBE_MLSTM
#define REP_ML REPX
#else
#define REP_ML
#endif
#ifdef PROBE_ATTN
#define REP_AT REPX
#else
#define REP_AT
#endif
#ifdef PROBE_GEMM
#define REP_GE REPX
#else
#define REP_GE
#endif
#define XN_ ((bf16*)(ws + WS_XN))
#define XN2_ ((bf16*)(ws + WS_XN2))
#define ACT_ ((bf16*)(ws + WS_ACT))
#define PROJ_ ((bf16*)(ws + WS_ACT))
#define GATES_ ((float*)(ws + WS_GATES))
#define AB_ ((float*)(ws + WS_AB))
#define MSb_ ((float*)(ws + WS_MS))
#define NS_ ((float*)(ws + WS_NS))
#define DN_ ((float*)(ws + WS_DN))
#define DCT_ ((float*)(ws + WS_DCT))
#define CTS_ ((bf16*)(ws + WS_CTS))
#define QB_ ((bf16*)(ws + WS_QB))
#define KVRAW_ ((float*)(ws + WS_KVRAW))
#define PART_ ((float*)(ws + WS_PART))

template <int l>
__device__ __forceinline__ void layer_body(LAS unsigned char* lds) {
        if (l == 2) REP_GE { PV pg8::EpiF32 E{KVRAW_, 512, ap->in[18]}; run_gemm(lds, XN2_, (const bf16*)(ws + WS_WKV), MT, 512, D, E, tid, bid, nb); }
        REP_GE { PV pg8::EpiSwiGLU E{ACT_, DFF}; run_gemm(lds, XN_, (const bf16*)(ws + WS_WGU + (size_t)(2 * l) * SZ_WGU), MT, NGU, D, E, tid, bid, nb); }
        GSYNC();
        { PV pg8::EpiResid E{XRES, D, nullptr, 0.5f}; run_gemm(lds, ACT_, (const bf16*)(ws + WS_WD + (size_t)(2 * l) * SZ_WD), MP, D, DFF, E, tid, bid, nb); }
        { PV run_gemm_sample_split<11>(lds, ACT_, (const bf16*)(ws + WS_WD + (size_t)(2 * l) * SZ_WD), DFF, PART_, nullptr, 0.5f, tid, bid, nb); }
#ifdef PROBE_DOWN
        { PV pg8::EpiResid E{XRES, D, nullptr, 0.0f}; run_gemm(lds, ACT_, (const bf16*)(ws + WS_WD + (size_t)(2 * l) * SZ_WD), MP, D, DFF, E, tid, bid, nb); }
        { PV run_gemm_sample_split<11>(lds, ACT_, (const bf16*)(ws + WS_WD + (size_t)(2 * l) * SZ_WD), DFF, PART_, nullptr, 0.5f, tid, bid, nb); }
#endif
        GSYNC();
        if (l < 2) { PV
            LAS float* wg = (LAS float*)(lds + 128);
            for (int i = tid; i < 8192; i += NTHR) wg[i] = ap->in[12][(size_t)l * D * APROJ + (size_t)(i >> 3) * APROJ + 3072 + (i & 7)];
            __syncthreads();
            norm_phase(XRES, XRES + (size_t)MP * D, nullptr, ap->in[11] + l * D, XN_, nullptr, nullptr, nullptr, wg, ap->in[13] + l * 8, GATES_, PART_, 11, XRES, gw, ngw, lane);
        } else {
            { PV norm_phase(XRES, XRES + (size_t)MP * D, nullptr, ap->in[11] + l * D, XN_, nullptr, nullptr, nullptr, nullptr, nullptr, nullptr, PART_, 11, XRES, gw, ngw, lane); }
#ifdef PROBE_NORM
        { PV norm_phase(XRES, XRES + (size_t)MP * D, nullptr, ap->in[11] + l * D, XN_, nullptr, nullptr, nullptr, nullptr, nullptr, nullptr, nullptr, 0, nullptr, gw, ngw, lane); }
#endif
            if (l == 2) { PV kv_finalize(ap, gtid, ngt); }
        }
        GSYNC();
        if (l < 2) {
            REP_GE { PV pg8::EpiBf16B E{PROJ_, NPROJ, nullptr}; run_gemm(lds, XN_, (const bf16*)(ws + WS_WIN + (size_t)l * SZ_WIN), MT, NPROJ, D, E, tid, bid, nb); }
            GSYNC();
            DUP_MA({ PV mlstm_a_units(PROJ_, GATES_, DCT_, DN_, AB_, lds, tid, wave, lane, bid, nb); })
            DUP_MA({ PV mlstm_sample_units(PROJ_, GATES_, ap->in[2] + (size_t)l * 128 * 4 * 128 * 256, ap->in[3] + (size_t)l * 128 * 4 * 128, ap->in[4] + (size_t)l * 512, ap->in[14] + l * D, XN_,
                               ap->out + OFF_SC + (size_t)l * 128 * 4 * 128 * 256, ap->out + OFF_SN + (size_t)l * 128 * 4 * 128, ap->out + OFF_SM + (size_t)l * 512, lds, tid, wave, lane, bid, nb); })
            GSYNC();
            DUP_MB({ PV mlstm_b(DCT_, DN_, AB_, CTS_, NS_, MSb_, ap->out + OFF_PC + (size_t)l * 262144, ap->out + OFF_PN + (size_t)l * 1024, ap->out + OFF_PM + (size_t)l * 8, gtid, ngt); })
            GSYNC();
            DUP_MC({ PV mlstm_c_units(PROJ_, GATES_, CTS_, NS_, MSb_, ap->in[14] + l * D, XN_, lds, tid, wave, lane, bid, nb); })
            GSYNC();
            { PV pg8::EpiResid E{XRES, D, nullptr, 1.0f}; run_gemm(lds, XN_, (const bf16*)(ws + WS_WOUT + (size_t)l * SZ_SQ), MP, D, D, E, tid, bid, nb); }
            { PV run_gemm_sample_split<4>(lds, XN_, (const bf16*)(ws + WS_WOUT + (size_t)l * SZ_SQ), D, PART_, nullptr, 1.0f, tid, bid, nb); }
        } else {
            const int j = l - 2;
            REP_GE { PV pg8::EpiBf16B E{QB_, D, ap->in[20] + j * D}; run_gemm(lds, XN_, (const bf16*)(ws + WS_WQ + (size_t)j * SZ_SQ), MP, D, D, E, tid, bid, nb); }
            { PV run_gemm_sample_split<4>(lds, XN_, (const bf16*)(ws + WS_WQ + (size_t)j * SZ_SQ), D, PART_, ap->in[20] + j * D, 1.0f, tid, bid, nb); }
            GSYNC();
            REP_AT { PV attn_units<16, false>(QB_, (const bf16*)(ws + WS_KB), (const bf16*)(ws + WS_VB), XN_, ap->in[21] + j * 16, (const float*)(ws + WS_ROPE), PART_, lds, tid, wave, lane, bid, nb); }
            REP_AT { PV attn_units<10, true>(QB_, (const bf16*)(ws + WS_SKB), (const bf16*)(ws + WS_SVB), XN_, ap->in[21] + j * 16, (const float*)(ws + WS_ROPE), PART_, lds, tid, wave, lane, bid, nb); }
            GSYNC();
            { PV pg8::EpiResid E{XRES, D, ap->in[23] + j * D, 1.0f}; run_gemm(lds, XN_, (const bf16*)(ws + WS_WO + (size_t)j * SZ_SQ), MP, D, D, E, tid, bid, nb); }
            { PV run_gemm_sample_split<4>(lds, XN_, (const bf16*)(ws + WS_WO + (size_t)j * SZ_SQ), D, PART_, ap->in[23] + j * D, 1.0f, tid, bid, nb); }
        }
        GSYNC();
        { PV norm_phase(XRES, XRES + (size_t)MP * D, nullptr, ap->in[7] + (2 * l + 1) * D, XN_, nullptr, nullptr, nullptr, nullptr, nullptr, nullptr, PART_, 4, XRES, gw, ngw, lane); }
#ifdef PROBE_NORM
        { PV norm_phase(XRES, XRES + (size_t)MP * D, nullptr, ap->in[7] + (2 * l + 1) * D, XN_, nullptr, nullptr, nullptr, nullptr, nullptr, nullptr, nullptr, 0, nullptr, gw, ngw, lane); }
#endif
        GSYNC();
        REP_GE { PV pg8::EpiSwiGLU E{ACT_, DFF}; run_gemm(lds, XN_, (const bf16*)(ws + WS_WGU + (size_t)(2 * l + 1) * SZ_WGU), MT, NGU, D, E, tid, bid, nb); }
        GSYNC();
        { PV pg8::EpiResid E{XRES, D, nullptr, 0.5f}; run_gemm(lds, ACT_, (const bf16*)(ws + WS_WD + (size_t)(2 * l + 1) * SZ_WD), MP, D, DFF, E, tid, bid, nb); }
        { PV run_gemm_sample_split<11>(lds, ACT_, (const bf16*)(ws + WS_WD + (size_t)(2 * l + 1) * SZ_WD), DFF, PART_, nullptr, 0.5f, tid, bid, nb); }
#ifdef PROBE_DOWN
        { PV pg8::EpiResid E{XRES, D, nullptr, 0.0f}; run_gemm(lds, ACT_, (const bf16*)(ws + WS_WD + (size_t)(2 * l + 1) * SZ_WD), MP, D, DFF, E, tid, bid, nb); }
        { PV run_gemm_sample_split<11>(lds, ACT_, (const bf16*)(ws + WS_WD + (size_t)(2 * l + 1) * SZ_WD), DFF, PART_, nullptr, 0.5f, tid, bid, nb); }
#endif
        GSYNC();
        if (l < 3) { PV norm_phase(XRES, XRES + (size_t)MP * D, nullptr, ap->in[7] + (2 * l + 2) * D, XN_, ap->in[16], (l == 1) ? XN2_ : nullptr, nullptr, nullptr, nullptr, nullptr, PART_, 11, XRES, gw, ngw, lane); }
#ifdef PROBE_NORM
        if (l < 3) { PV norm_phase(XRES, XRES + (size_t)MP * D, nullptr, ap->in[7] + (2 * l + 2) * D, XN_, ap->in[16], (l == 1) ? XN2_ : nullptr, nullptr, nullptr, nullptr, nullptr, nullptr, 0, nullptr, gw, ngw, lane); }
#endif
        else { PV norm_phase(XRES, XRES + (size_t)MP * D, nullptr, ap->in[24], nullptr, nullptr, nullptr, XRES, nullptr, nullptr, nullptr, PART_, 11, nullptr, gw, ngw, lane); }
        if (l < 3) GSYNC();
}

__global__ void __launch_bounds__(NTHR, 2) mk_fwd(Args a) {
    extern __shared__ __attribute__((aligned(16))) unsigned char lds_raw[];
    LAS unsigned char* lds = (LAS unsigned char*)lds_raw;
    cg::grid_group grid = cg::this_grid();
    if (a.ws == nullptr) grid.sync();
    volatile LAS unsigned* bst = (volatile LAS unsigned*)(lds + LDS_BYTES - 64);
    if (threadIdx.x < 16) bst[threadIdx.x] = 0u;
    __syncthreads();
    (void)xcd_barrier_post((unsigned*)a.ws, bst);


    REP_P0 { PV rope_table(ap, gw, ngw, lane); convert_group<0>(ap, lds, wave, lane, gw, ngw); convert_group<1>(ap, lds, wave, lane, gw, ngw); convert_group<2>(ap, lds, wave, lane, gw, ngw); convert_group<3>(ap, lds, wave, lane, gw, ngw); }
    { PV norm_phase(ap->in[0], ap->in[1], XRES, ap->in[7], XN_, nullptr, nullptr, nullptr, nullptr, nullptr, nullptr, nullptr, 0, nullptr, gw, ngw, lane); }
    GSYNC();

    layer_body<0>(lds); layer_body<1>(lds); layer_body<2>(lds); layer_body<3>(lds);
}

extern "C" void kernel_launch(void* const* d_in, const int* in_sizes, int n_in, void* d_out, int out_size, void* d_ws, size_t ws_size, hipStream_t stream) {
    static int grid = 0;
    if (grid == 0) {
        if (n_in != 25 || (size_t)out_size != OUT_TOTAL || ws_size < WS_TOTAL) {
            fprintf(stderr, "kernel_launch: unexpected shapes: n_in %d out %d ws %zu (need %zu)\n", n_in, out_size, ws_size, (size_t)WS_TOTAL); grid = -1; return; }
        int dev = 0, cus = 0, per_cu = 0;
        (void)hipGetDevice(&dev); (void)hipDeviceGetAttribute(&cus, hipDeviceAttributeMultiprocessorCount, dev);
        (void)hipFuncSetAttribute((const void*)mk_fwd, hipFuncAttributeMaxDynamicSharedMemorySize, LDS_BYTES);
        if (hipOccupancyMaxActiveBlocksPerMultiprocessor(&per_cu, (const void*)mk_fwd, NTHR, LDS_BYTES) != hipSuccess || per_cu < 1) per_cu = 1;
        (void)hipGetLastError();
        if (cus <= 0) cus = 256;
        grid = cus;
    }
    if (grid < 0) return;
    (void)hipMemsetAsync(d_ws, 0, 16384, stream);
    Args a{};
    for (int i = 0; i < 25; ++i) a.in[i] = (const float*)d_in[i];
    a.out = (float*)d_out; a.ws = (unsigned char*)d_ws;
    void* args[] = {&a};
    hipError_t e = hipLaunchCooperativeKernel((const void*)mk_fwd, dim3(grid), dim3(NTHR), args, LDS_BYTES, stream);
    if (e != hipSuccess) fprintf(stderr, "cooperative launch failed: %s (grid %d)\n", hipGetErrorString(e), grid);
}
```

```cpp
#include <hip/hip_runtime.h>
#include <hip/hip_cooperative_groups.h>
#include <cstdio>
#include <cstdint>
namespace cg = cooperative_groups;
namespace pg8 {
#define PG8_LAS __attribute__((address_space(3)))
typedef unsigned short bf16_t;
typedef short bf16x8 __attribute__((ext_vector_type(8)));
typedef float f32x4 __attribute__((ext_vector_type(4)));
typedef unsigned u32x4 __attribute__((ext_vector_type(4)));
constexpr int BM = 256, BK = 64, HALF = 128, HTB = HALF * BK * 2  , STAGE_BYTES = 8 * HTB, NXCD = 8, WGM = 8;

__host__ __device__ __forceinline__ int lds_byte(int r, int c) { const int st = (r >> 4) * 2 + (c >> 5), rr = r & 15, cc = c & 31, ob = rr * 64 + cc * 2; return st * 1024 + (ob ^ (((ob >> 9) & 1) << 5)); }
__host__ __device__ __forceinline__ void stage_rc(int b, int& R, int& C) { const int st = b / 1024, sb = b % 1024, swz = sb ^ (((sb >> 9) & 1) << 5); R = (st >> 1) * 16 + swz / 64; C = (st & 1) * 32 + (swz % 64) / 2; }
__host__ __device__ __forceinline__ int perm32(int rho) { const int n = rho >> 4, i = rho & 15; return 8 * (i >> 2) + 4 * n + (i & 3); }

struct Unit { int pm, pn; };
struct Gemm { const bf16_t* A; const bf16_t* Bt; int M, N, K, nt; };

struct StaticOrder {
    int nM, nN, nwg, G, c;
    __host__ __device__ void init(int M, int N, int G_, int c_) { nM = M / BM; nN = N / BM; nwg = nM * nN; G = G_; c = c_; }
    __host__ __device__ bool next(int i, Unit& u) const {
        const long L = (long)i * G + c; if (L >= nwg) return false;
        int wgid = (int)L; { const int q = nwg / NXCD, r = nwg % NXCD, xcd = wgid % NXCD, off = wgid / NXCD; wgid = (xcd < r ? xcd * (q + 1) : r * (q + 1) + (xcd - r) * q) + off; }
        const int nig = WGM * nN, gid = wgid / nig, fm = gid * WGM, gsz = (nM - fm) < WGM ? (nM - fm) : WGM;
        u.pm = fm + ((wgid % nig) % gsz); u.pn = (wgid % nig) / gsz; return true;
    }
    __device__ __forceinline__ void a_ready(const Unit&) const {}
    __device__ __forceinline__ void done(const Unit&) const {}
};

__device__ __forceinline__ unsigned cvt_pk_bf16(float lo, float hi) { unsigned r; asm volatile("v_cvt_pk_bf16_f32 %0, %1, %2" : "=v"(r) : "v"(lo), "v"(hi)); return r; }
typedef float f32x2 __attribute__((ext_vector_type(2)));
struct EpiBf16B {
    static constexpr bool PERM = true, AFTER_DRAIN = false;
    bf16_t* O; int ldc; const float* bias;
    __device__ __forceinline__ void operator()(const f32x4 (&acc)[2][2][4][2], const Unit& u, int wr, int wc, int fr, int fq) const {
        const int row0 = u.pm * BM + wr * 64 + fr; const int col0 = u.pn * BM + wc * 32 + 8 * fq;
        f32x4 bv[2][2];
#pragma unroll
        for (int bj = 0; bj < 2; ++bj)
#pragma unroll
            for (int n = 0; n < 2; ++n) bv[bj][n] = bias ? *(const f32x4*)(bias + col0 + bj * HALF + 4 * n) : (f32x4){0.f, 0.f, 0.f, 0.f};
#pragma unroll
        for (int ai = 0; ai < 2; ++ai)
#pragma unroll
            for (int m = 0; m < 4; ++m) { bf16_t* rowp = O + (size_t)(row0 + ai * HALF + m * 16) * ldc + col0;
#pragma unroll
                for (int bj = 0; bj < 2; ++bj) { const f32x4 v0 = acc[ai][bj][m][0] + bv[bj][0], v1 = acc[ai][bj][m][1] + bv[bj][1];
                    u32x4 w; w.x = cvt_pk_bf16(v0[0], v0[1]); w.y = cvt_pk_bf16(v0[2], v0[3]); w.z = cvt_pk_bf16(v1[0], v1[1]); w.w = cvt_pk_bf16(v1[2], v1[3]);
                    *(u32x4*)(rowp + bj * HALF) = w; } }
    }
};
__device__ __forceinline__ float silu_mul(float g, float u) { return g * u * __builtin_amdgcn_rcpf(1.0f + __builtin_amdgcn_exp2f(g * -1.4426950408889634f)); }
struct EpiSwiGLU {
    static constexpr bool PERM = true, AFTER_DRAIN = false;
    bf16_t* O; int ldc;
    __device__ __forceinline__ void operator()(const f32x4 (&acc)[2][2][4][2], const Unit& u, int wr, int wc, int fr, int fq) const {
        const int row0 = u.pm * BM + wr * 64 + fr; const int col0 = u.pn * HALF + wc * 32 + 8 * fq;
#pragma unroll
        for (int ai = 0; ai < 2; ++ai)
#pragma unroll
            for (int m = 0; m < 4; ++m) { bf16_t* rowp = O + (size_t)(row0 + ai * HALF + m * 16) * ldc + col0;
                const f32x4 g0 = acc[ai][0][m][0], g1 = acc[ai][0][m][1], u0 = acc[ai][1][m][0], u1 = acc[ai][1][m][1];
                u32x4 w; w.x = cvt_pk_bf16(silu_mul(g0[0], u0[0]), silu_mul(g0[1], u0[1])); w.y = cvt_pk_bf16(silu_mul(g0[2], u0[2]), silu_mul(g0[3], u0[3]));
                w.z = cvt_pk_bf16(silu_mul(g1[0], u1[0]), silu_mul(g1[1], u1[1])); w.w = cvt_pk_bf16(silu_mul(g1[2], u1[2]), silu_mul(g1[3], u1[3]));
                *(u32x4*)rowp = w; }
    }
};
struct EpiResid {
    static constexpr bool PERM = false, AFTER_DRAIN = false;
    float* X; int ldc; const float* bias; float scale;
    __device__ __forceinline__ void operator()(const f32x4 (&acc)[2][2][4][2], const Unit& u, int wr, int wc, int fr, int fq) const {
        const int col0 = u.pn * BM + wc * 32 + 4 * fq;
        f32x4 bv[2][2];
#pragma unroll
        for (int bj = 0; bj < 2; ++bj)
#pragma unroll
            for (int n = 0; n < 2; ++n) bv[bj][n] = bias ? *(const f32x4*)(bias + col0 + bj * HALF + n * 16) : (f32x4){0.f, 0.f, 0.f, 0.f};
#pragma unroll
        for (int ai = 0; ai < 2; ++ai) {
            float* base = X + (size_t)(u.pm * BM + ai * HALF + wr * 64 + fr) * ldc + col0;
            f32x4 old[4][2][2];
#pragma unroll
            for (int m = 0; m < 4; ++m)
#pragma unroll
                for (int bj = 0; bj < 2; ++bj)
#pragma unroll
                    for (int n = 0; n < 2; ++n) old[m][bj][n] = *(const f32x4*)(base + (size_t)(m * 16) * ldc + bj * HALF + n * 16);
#pragma unroll
            for (int m = 0; m < 4; ++m)
#pragma unroll
                for (int bj = 0; bj < 2; ++bj)
#pragma unroll
                    for (int n = 0; n < 2; ++n) *(f32x4*)(base + (size_t)(m * 16) * ldc + bj * HALF + n * 16) = old[m][bj][n] + (acc[ai][bj][m][n] + bv[bj][n]) * scale;
            asm volatile("" ::: "memory"); }
    }
};
struct EpiF32 {
    static constexpr bool PERM = false, AFTER_DRAIN = false;
    float* O; int ldc; const float* bias;
    __device__ __forceinline__ void operator()(const f32x4 (&acc)[2][2][4][2], const Unit& u, int wr, int wc, int fr, int fq) const {
        const int col0 = u.pn * BM + wc * 32 + 4 * fq;
#pragma unroll
        for (int ai = 0; ai < 2; ++ai)
#pragma unroll
            for (int m = 0; m < 4; ++m) { float* rowp = O + (size_t)(u.pm * BM + ai * HALF + wr * 64 + m * 16 + fr) * ldc + col0;
#pragma unroll
                for (int bj = 0; bj < 2; ++bj)
#pragma unroll
                    for (int n = 0; n < 2; ++n) { const f32x4 bvv = *(const f32x4*)(bias + col0 + bj * HALF + n * 16); *(f32x4*)(rowp + bj * HALF + n * 16) = acc[ai][bj][m][n] + bvv; } }
    }
};
struct OneUnit {
    int pm, pn; bool has;
    __device__ __forceinline__ bool next(int i, Unit& u) const { if (i == 0 && has) { u.pm = pm; u.pn = pn; return true; } return false; }
    __device__ __forceinline__ void a_ready(const Unit&) const {}
    __device__ __forceinline__ void done(const Unit&) const {}
};
struct EpiPartial {
    static constexpr bool PERM = false, AFTER_DRAIN = false;
    float* P; const float* bias; float scale; bool addbias;
    __device__ __forceinline__ void operator()(const f32x4 (&acc)[2][2][4][2], const Unit& u, int wr, int wc, int fr, int fq) const {
        const int col0 = u.pn * BM + wc * 32 + 4 * fq;
        f32x4 bv[2][2];
#pragma unroll
        for (int bj = 0; bj < 2; ++bj)
#pragma unroll
            for (int n = 0; n < 2; ++n) bv[bj][n] = (bias && addbias) ? *(const f32x4*)(bias + col0 + bj * HALF + n * 16) : (f32x4){0.f, 0.f, 0.f, 0.f};
#pragma unroll
        for (int ai = 0; ai < 2; ++ai)
#pragma unroll
            for (int m = 0; m < 4; ++m) { float* rowp = P + (size_t)((u.pm - 64) * BM + ai * HALF + wr * 64 + m * 16 + fr) * 1024 + col0;
#pragma unroll
                for (int bj = 0; bj < 2; ++bj)
#pragma unroll
                    for (int n = 0; n < 2; ++n) *(f32x4*)(rowp + bj * HALF + n * 16) = (acc[ai][bj][m][n] + bv[bj][n]) * scale; }
    }
};
template <class Epi, class Sched, bool ALIGN_EPI = false, bool SP2 = false>
__device__ __forceinline__ void gemm_phase(PG8_LAS unsigned char* lds, const Gemm g, const Sched& S, const Epi& E, const int tid_in) {
    const int tid = tid_in, wid = __builtin_amdgcn_readfirstlane(tid >> 6), lane = tid & 63, wr = wid >> 2, wc = wid & 3, fr = lane & 15, fq = lane >> 4;
    const int K = g.K, nt = g.nt;
    unsigned voffA[2], voffB[2];
#pragma unroll
    for (int i = 0; i < 2; ++i) { int R, C; stage_rc(tid * 16 + i * 8192, R, C); const int Rb = Epi::PERM ? ((R & ~31) + perm32(R & 31)) : R;
        voffA[i] = (unsigned)(R * K + C) * 2u; voffB[i] = (unsigned)(Rb * K + C) * 2u; }
    const size_t kstep = (size_t)(BK * 2);
    const size_t hstep = (size_t)HALF * K * 2;
    const size_t tstep = 2 * hstep;
    const unsigned ldsw = (unsigned)wid * 1024u;
    const int aoff = lds_byte(wr * 64 + fr, fq * 8), boff = lds_byte(wc * 32 + fr, fq * 8);
#define PG8_SA(b, h) (((b) * 2 + (h)) * HTB)
#define PG8_SB(b, h) ((4 + (b) * 2 + (h)) * HTB)
#define PG8_STAGE(bufoff, gbase, voff) do { _Pragma("unroll") for (int _i = 0; _i < 2; ++_i) \
        __builtin_amdgcn_global_load_lds((const unsigned*)((const char*)(gbase) + (voff)[_i]), (PG8_LAS unsigned*)(lds + (bufoff) + ldsw + _i * 8192), 16, 0, 0); } while (0)
#define PG8_LDA(dst, b, h) do { _Pragma("unroll") for (int m = 0; m < 4; ++m) _Pragma("unroll") for (int k = 0; k < 2; ++k) dst[m][k] = *(const PG8_LAS bf16x8*)(lds + PG8_SA(b, h) + aoff + m * 2048 + k * 1024); } while (0)
#define PG8_LDB(dst, b, h) do { _Pragma("unroll") for (int n = 0; n < 2; ++n) _Pragma("unroll") for (int k = 0; k < 2; ++k) dst[n][k] = *(const PG8_LAS bf16x8*)(lds + PG8_SB(b, h) + boff + n * 2048 + k * 1024); } while (0)
#define PG8_MMA(ai, bj, At, Bt) do { __builtin_amdgcn_s_setprio(1); _Pragma("unroll") for (int m = 0; m < 4; ++m) _Pragma("unroll") for (int n = 0; n < 2; ++n) _Pragma("unroll") for (int k = 0; k < 2; ++k) \
        acc[ai][bj][m][n] = __builtin_amdgcn_mfma_f32_16x16x32_bf16(Bt[n][k], At[m][k], acc[ai][bj][m][n], 0, 0, 0); __builtin_amdgcn_s_setprio(0); } while (0)
#define PG8_WAIT_V(n) asm volatile("s_waitcnt vmcnt(" #n ")" ::: "memory")
#define PG8_WAIT_L(n) asm volatile("s_waitcnt lgkmcnt(" #n ")" ::: "memory")
#define PG8_BAR __builtin_amdgcn_s_barrier()
#define PG8_SCHED __builtin_amdgcn_sched_barrier(0)
    Unit cur, nxt; int ui = 0;
    if (!S.next(0, cur)) return;
    f32x4 acc[2][2][4][2];
#pragma unroll
    for (int a = 0; a < 2; ++a)
#pragma unroll
        for (int b = 0; b < 2; ++b)
#pragma unroll
            for (int m = 0; m < 4; ++m)
#pragma unroll
                for (int n = 0; n < 2; ++n) acc[a][b][m][n] = (f32x4){0.f, 0.f, 0.f, 0.f};
    bf16x8 At[4][2], B0[2][2], B1[2][2];
    const char* cA = (const char*)g.A + (size_t)cur.pm * tstep; const char* cB = (const char*)g.Bt + (size_t)cur.pn * tstep;
    S.a_ready(cur);
    if constexpr (SP2) {
        PG8_STAGE(PG8_SB(0, 0), cB, voffB); PG8_STAGE(PG8_SB(0, 1), cB + hstep, voffB); PG8_STAGE(PG8_SA(0, 0), cA, voffA); PG8_STAGE(PG8_SA(0, 1), cA + hstep, voffA);
        if (wr == 1) PG8_BAR;
        PG8_WAIT_V(2); PG8_BAR;
        PG8_STAGE(PG8_SB(1, 0), cB + kstep, voffB); PG8_STAGE(PG8_SA(1, 0), cA + kstep, voffA); PG8_STAGE(PG8_SB(1, 1), cB + hstep + kstep, voffB);
        PG8_WAIT_V(6); PG8_BAR;
    } else {
        PG8_STAGE(PG8_SB(0, 0), cB, voffB); PG8_STAGE(PG8_SA(0, 0), cA, voffA); PG8_STAGE(PG8_SB(0, 1), cB + hstep, voffB); PG8_STAGE(PG8_SA(0, 1), cA + hstep, voffA);
        if (wr == 1) PG8_BAR;
        PG8_WAIT_V(4); PG8_BAR;
        PG8_STAGE(PG8_SB(1, 0), cB + kstep, voffB); PG8_STAGE(PG8_SA(1, 0), cA + kstep, voffA); PG8_STAGE(PG8_SB(1, 1), cB + hstep + kstep, voffB);
        PG8_WAIT_V(6); PG8_BAR;
    }
    for (;;) {
        const bool has_next = S.next(ui + 1, nxt);
        const char* nA = has_next ? (const char*)g.A + (size_t)nxt.pm * tstep : cA; const char* nB = has_next ? (const char*)g.Bt + (size_t)nxt.pn * tstep : cB;
        for (int t = 0; t < nt; t += 2) {
            const bool last = (t == nt - 2);
            const char* a1 = cA + (size_t)(t + 1) * kstep;
            const char* a2 = last ? nA : cA + (size_t)(t + 2) * kstep; const char* b2 = last ? nB : cB + (size_t)(t + 2) * kstep;
            const char* a3 = a2 + kstep; const char* b3 = b2 + kstep;
            if (last && has_next) S.a_ready(nxt);
            if constexpr (SP2) {
            PG8_LDB(B0, 0, 0); PG8_LDB(B1, 0, 1); PG8_SCHED; PG8_LDA(At, 0, 0); PG8_STAGE(PG8_SA(1, 1), a1 + hstep, voffA);
            PG8_WAIT_V(8); PG8_WAIT_L(0); PG8_BAR; PG8_MMA(0, 0, At, B0); PG8_MMA(0, 1, At, B1); PG8_BAR; PG8_SCHED;
            PG8_LDA(At, 0, 1); PG8_STAGE(PG8_SB(0, 0), b2, voffB); PG8_STAGE(PG8_SB(0, 1), b2 + hstep, voffB); PG8_STAGE(PG8_SA(0, 0), a2, voffA);
            PG8_WAIT_V(8); PG8_WAIT_L(0); PG8_BAR; PG8_MMA(1, 0, At, B0); PG8_MMA(1, 1, At, B1); PG8_BAR; PG8_SCHED;
            PG8_LDB(B0, 1, 0); PG8_LDB(B1, 1, 1); PG8_SCHED; PG8_LDA(At, 1, 0); PG8_STAGE(PG8_SA(0, 1), a2 + hstep, voffA);
            PG8_WAIT_V(8); PG8_WAIT_L(0); PG8_BAR; PG8_MMA(0, 0, At, B0); PG8_MMA(0, 1, At, B1); PG8_BAR; PG8_SCHED;
            PG8_LDA(At, 1, 1); PG8_STAGE(PG8_SB(1, 0), b3, voffB); PG8_STAGE(PG8_SB(1, 1), b3 + hstep, voffB); PG8_STAGE(PG8_SA(1, 0), a3, voffA);
            PG8_WAIT_V(8); PG8_WAIT_L(0); PG8_BAR; PG8_MMA(1, 0, At, B0); PG8_MMA(1, 1, At, B1); PG8_BAR; PG8_SCHED;
            } else {
            PG8_LDB(B0, 0, 0); PG8_SCHED; PG8_LDA(At, 0, 0); PG8_STAGE(PG8_SA(1, 1), a1 + hstep, voffA);
            PG8_WAIT_L(8); PG8_BAR; PG8_WAIT_L(0); PG8_MMA(0, 0, At, B0); PG8_BAR; PG8_SCHED;
            PG8_LDB(B1, 0, 1); PG8_STAGE(PG8_SB(0, 0), b2, voffB);
            PG8_BAR; PG8_WAIT_L(0); PG8_MMA(0, 1, At, B1); PG8_BAR;
            PG8_LDA(At, 0, 1); PG8_STAGE(PG8_SA(0, 0), a2, voffA);
            PG8_BAR; PG8_WAIT_L(0); PG8_MMA(1, 0, At, B0); PG8_BAR; PG8_SCHED;
            PG8_STAGE(PG8_SB(0, 1), b2 + hstep, voffB);
            PG8_WAIT_V(6); PG8_BAR; PG8_MMA(1, 1, At, B1); PG8_BAR;
            PG8_LDB(B0, 1, 0); PG8_SCHED; PG8_LDA(At, 1, 0); PG8_STAGE(PG8_SA(0, 1), a2 + hstep, voffA);
            PG8_WAIT_L(8); PG8_BAR; PG8_WAIT_L(0); PG8_MMA(0, 0, At, B0); PG8_BAR; PG8_SCHED;
            PG8_LDB(B1, 1, 1); PG8_STAGE(PG8_SB(1, 0), b3, voffB);
            PG8_BAR; PG8_WAIT_L(0); PG8_MMA(0, 1, At, B1); PG8_BAR;
            PG8_LDA(At, 1, 1); PG8_STAGE(PG8_SA(1, 0), a3, voffA);
            PG8_BAR; PG8_WAIT_L(0); PG8_MMA(1, 0, At, B0); PG8_BAR; PG8_SCHED;
            PG8_STAGE(PG8_SB(1, 1), b3 + hstep, voffB);
            PG8_WAIT_V(6); PG8_BAR; PG8_MMA(1, 1, At, B1); PG8_BAR;
            }
        }
        if constexpr (ALIGN_EPI) { if (wr == 0) PG8_BAR; }
        if constexpr (!Epi::AFTER_DRAIN) { E(acc, cur, wr, wc, fr, fq); S.done(cur); }
        if (!has_next) break;
#pragma unroll
        for (int a = 0; a < 2; ++a)
#pragma unroll
            for (int b = 0; b < 2; ++b)
#pragma unroll
                for (int m = 0; m < 4; ++m)
#pragma unroll
                    for (int n = 0; n < 2; ++n) acc[a][b][m][n] = (f32x4){0.f, 0.f, 0.f, 0.f};
        cur = nxt; cA = nA; cB = nB; ++ui;
        if constexpr (ALIGN_EPI) { if (wr == 1) PG8_BAR; }
    }
    PG8_WAIT_V(0);
    if constexpr (!ALIGN_EPI) { if (wr == 0) PG8_BAR; }
    PG8_BAR;
    if constexpr (Epi::AFTER_DRAIN) { E.fused(acc, cur, wr, wc, fr, fq, lds, wid, lane); S.done(cur); }
#undef PG8_SA
#undef PG8_SB
#undef PG8_STAGE
#undef PG8_LDA
#undef PG8_LDB
#undef PG8_MMA
#undef PG8_WAIT_V
#undef PG8_WAIT_L
#undef PG8_BAR
#undef PG8_SCHED
}
}

#define LAS __attribute__((address_space(3)))
typedef unsigned short bf16;
typedef unsigned u32x4 __attribute__((ext_vector_type(4)));
typedef unsigned u32x2 __attribute__((ext_vector_type(2)));
typedef float f32x4 __attribute__((ext_vector_type(4)));
typedef float f32x2v __attribute__((ext_vector_type(2)));
typedef short bf16x8 __attribute__((ext_vector_type(8)));
#define LDS_WAIT() asm volatile("s_waitcnt lgkmcnt(0)" ::: "memory")

constexpr int D = 1024, MP = 16384, MSAMP = 1024, MT = 17408, DFF = 2816, NGU = 5632, NPROJ = 3072, APROJ = 3080;
constexpr int NTHR = 512;
constexpr float KSCALE = 0.08838834764831845f;
constexpr float EPS = 1e-6f;

constexpr size_t MiB = (size_t)1 << 20;
constexpr size_t SZ_WGU = (size_t)NGU * D * 2, SZ_WD = (size_t)D * DFF * 2, SZ_WIN = (size_t)NPROJ * D * 2, SZ_SQ = (size_t)D * D * 2;
constexpr size_t WS_ROPE = 65536;
constexpr size_t WS_WGU = 1 * MiB;
constexpr size_t WS_WD = WS_WGU + 8 * SZ_WGU;
constexpr size_t WS_WIN = WS_WD + 8 * SZ_WD;
constexpr size_t WS_WOUT = WS_WIN + 2 * SZ_WIN;
constexpr size_t WS_WKV = WS_WOUT + 2 * SZ_SQ;
constexpr size_t WS_WQ = WS_WKV + (size_t)512 * D * 2;
constexpr size_t WS_WO = WS_WQ + 2 * SZ_SQ;
constexpr size_t WS_XN = WS_WO + 2 * SZ_SQ;
constexpr size_t WS_ACT = WS_XN + (size_t)MT * D * 2;
constexpr size_t WS_GATES = WS_ACT + (size_t)MT * NPROJ * 2;
constexpr size_t WS_AB = WS_GATES + (size_t)MT * 8 * 4;
constexpr size_t WS_MS = WS_AB + 8192;
constexpr size_t WS_NS = WS_MS + 8192;
constexpr size_t WS_DN = WS_NS + (size_t)8 * 129 * 128 * 4;
constexpr size_t WS_R1 = ((WS_DN + (size_t)1024 * 128 * 4 + MiB - 1) / MiB) * MiB;
constexpr size_t WS_DCT = WS_R1;
constexpr size_t WS_CTS = WS_DCT + (size_t)1024 * 32768 * 4;
constexpr size_t WS_XN2 = WS_R1;
constexpr size_t WS_QB = WS_XN2 + (size_t)MT * D * 2;
constexpr size_t WS_KVRAW = WS_QB + (size_t)MT * D * 2;
constexpr size_t WS_KB = WS_KVRAW + (size_t)MT * 512 * 4;
constexpr size_t WS_VB = WS_KB + (size_t)MP * 256 * 2;
constexpr size_t WS_SKB = WS_VB + (size_t)MP * 256 * 2;
constexpr size_t WS_SVB = WS_SKB + (size_t)128 * 136 * 256 * 2;
constexpr size_t WS_END = WS_R1 + 192 * MiB;
constexpr size_t WS_PART = WS_END;
constexpr size_t WS_TOTAL = WS_PART + 44 * MiB;
static_assert(WS_SVB + (size_t)128 * 136 * 256 * 2 <= WS_END && WS_CTS + (size_t)1024 * 32768 * 2 <= WS_END, "ws map");

constexpr size_t OFF_Y = 0;
constexpr size_t OFF_PC = (size_t)MT * D;
constexpr size_t OFF_PN = OFF_PC + 524288;
constexpr size_t OFF_PM = OFF_PN + 2048;
constexpr size_t OFF_PK = OFF_PM + 16;
constexpr size_t OFF_PV = OFF_PK + 65536;
constexpr size_t OFF_SC = OFF_PV + 65536;
constexpr size_t OFF_SN = OFF_SC + 33554432;
constexpr size_t OFF_SM = OFF_SN + 131072;
constexpr size_t OFF_SK = OFF_SM + 1024;
constexpr size_t OFF_SV = OFF_SK + 4194304;
constexpr size_t OUT_TOTAL = OFF_SV + 4194304;

constexpr int LDS_BYTES = 147456;

struct Args { const float* in[25]; float* out; unsigned char* ws; };
typedef const __attribute__((address_space(4))) Args* ArgsP;

__device__ __forceinline__ unsigned f2bf(float f) { unsigned u = __builtin_bit_cast(unsigned, f); return (u + 0x7fffu + ((u >> 16) & 1u)) >> 16; }
__device__ __forceinline__ unsigned pk2(float lo, float hi) { return f2bf(lo) | (f2bf(hi) << 16); }
__device__ __forceinline__ float bf2f(unsigned h) { return __builtin_bit_cast(float, h << 16); }
__device__ __forceinline__ float bflo(unsigned w) { return __builtin_bit_cast(float, w << 16); }
__device__ __forceinline__ float bfhi(unsigned w) { return __builtin_bit_cast(float, w & 0xffff0000u); }
__device__ __forceinline__ float wave_sum(float v) {
#pragma unroll
    for (int o = 1; o < 64; o <<= 1) v += __shfl_xor(v, o);
    return v;
}
__device__ __forceinline__ float wave_max(float v) {
#pragma unroll
    for (int o = 1; o < 64; o <<= 1) v = fmaxf(v, __shfl_xor(v, o));
    return v;
}
__device__ __forceinline__ f32x4 mfma16(bf16x8 a, bf16x8 b, f32x4 c) { return __builtin_amdgcn_mfma_f32_16x16x32_bf16(a, b, c, 0, 0, 0); }
__device__ __forceinline__ void rope_cs(int pos, double invf, float& c, float& s) {
    const double ang = (double)pos * invf;
    const double r = ang - 6.283185307179586476925 * __builtin_rint(ang * 0.15915494309189533577);
    const float rf = (float)r; c = cosf(rf); s = sinf(rf);
}
#define ROPE_INVF { 1.0, 0.1939227447486858, 0.03760603093086394, 0.007292664737217109, 0.0014142135623730955, 0.00027424817567620724, 5.318295896944988e-05, 1.0313385377212461e-05 }

__device__ __forceinline__ void cvt_item(const float* W, int ldw, int k0, int n0, bf16* dst, int K, LAS float* scr, int lane) {
#pragma unroll 4
    for (int i = 0; i < 16; ++i) { const int kk = 4 * i + (lane >> 4); const f32x4 v = *(const f32x4*)(W + (size_t)(k0 + kk) * ldw + n0 + 4 * (lane & 15));
        LAS float* s = scr + kk * 65 + 4 * (lane & 15); s[0] = v.x; s[1] = v.y; s[2] = v.z; s[3] = v.w; }
    LDS_WAIT();
    const int c = lane & 7, nn = lane >> 3;
#pragma unroll
    for (int j = 0; j < 8; ++j) { const int n = nn + 8 * j; const LAS float* s = scr + (8 * c) * 65 + n;
        u32x4 o; o.x = pk2(s[0], s[65]); o.y = pk2(s[130], s[195]); o.z = pk2(s[260], s[325]); o.w = pk2(s[390], s[455]);
        *(u32x4*)(dst + (size_t)n * K + k0 + 8 * c) = o; }
    LDS_WAIT();
}
__device__ __forceinline__ void rope_table(ArgsP a, int gw, int ngw, int lane) {
    const double invf[8] = ROPE_INVF; float* rt = (float*)(a->ws + WS_ROPE);
    for (int it = gw * 64 + lane; it < 8200 * 8; it += ngw * 64) { const int pos = it >> 3, i = it & 7; double f = invf[0];
#pragma unroll
        for (int q = 1; q < 8; ++q) f = (i == q) ? invf[q] : f;
        float c, s; rope_cs(pos, f, c, s); rt[pos * 16 + i] = c; rt[pos * 16 + 8 + i] = s; }
}
template <int L>
__device__ __forceinline__ void convert_group(ArgsP a, LAS unsigned char* lds, int wave, int lane, int gw, int ngw) {
    LAS float* scr = (LAS float*)(lds + wave * 16640);
    unsigned char* ws = a->ws;
    constexpr int I_G = 16 * 44, I_D = 44 * 16, I_FF = 2 * I_G + I_D, I_IN = 16 * 48, I_SQ = 256, I_KV = 16 * 8;
    constexpr int NITEMS = 2 * I_FF + (L < 2 ? I_IN + I_SQ : (L == 2 ? I_KV + 2 * I_SQ : 2 * I_SQ));
    for (int it = gw; it < NITEMS; it += ngw) {
        int r = it;
        if (r < 2 * I_FF) { const int li = 2 * L + r / I_FF; r %= I_FF;
            if (r < 2 * I_G) { const int up = (r >= I_G) ? 1 : 0; r -= up * I_G; const int kb = r / 44, nb = r % 44; const int n0 = nb * 64;
                const float* W = (up ? a->in[9] : a->in[8]) + (size_t)li * D * DFF;
                bf16* dst = (bf16*)(ws + WS_WGU + (size_t)li * SZ_WGU) + (size_t)((n0 >> 7) * 256 + (n0 & 127) + up * 128) * D;
                cvt_item(W, DFF, kb * 64, n0, dst, D, scr, lane);
            } else { r -= 2 * I_G; const int kb = r / 16, nb = r % 16;
                cvt_item(a->in[10] + (size_t)li * DFF * D, D, kb * 64, nb * 64, (bf16*)(ws + WS_WD + (size_t)li * SZ_WD) + (size_t)nb * 64 * DFF, DFF, scr, lane); }
            continue; }
        r -= 2 * I_FF;
        if (L < 2) {
            if (r < I_IN) { const int kb = r / 48, nb = r % 48;
                cvt_item(a->in[12] + (size_t)L * D * APROJ, APROJ, kb * 64, nb * 64, (bf16*)(ws + WS_WIN + (size_t)L * SZ_WIN) + (size_t)nb * 64 * D, D, scr, lane); continue; }
            r -= I_IN; { const int kb = r / 16, nb = r % 16;
                cvt_item(a->in[15] + (size_t)L * D * D, D, kb * 64, nb * 64, (bf16*)(ws + WS_WOUT + (size_t)L * SZ_SQ) + (size_t)nb * 64 * D, D, scr, lane); }
        } else {
            if (L == 2) { if (r < I_KV) { const int kb = r / 8, nb = r % 8;
                    cvt_item(a->in[17], 512, kb * 64, nb * 64, (bf16*)(ws + WS_WKV) + (size_t)nb * 64 * D, D, scr, lane); continue; }
                r -= I_KV; }
            const int j = L - 2;
            if (r < I_SQ) { const int kb = r / 16, nb = r % 16;
                cvt_item(a->in[19] + (size_t)j * D * D, D, kb * 64, nb * 64, (bf16*)(ws + WS_WQ + (size_t)j * SZ_SQ) + (size_t)nb * 64 * D, D, scr, lane); continue; }
            r -= I_SQ; { const int kb = r / 16, nb = r % 16;
                cvt_item(a->in[22] + (size_t)j * D * D, D, kb * 64, nb * 64, (bf16*)(ws + WS_WO + (size_t)j * SZ_SQ) + (size_t)nb * 64 * D, D, scr, lane); }
        }
    }
}

__device__ __forceinline__ void norm_phase(const float* srcP, const float* srcS, float* xcopy, const float* g1, bf16* o1, const float* g2, bf16* o2, float* fout,
                                           const LAS float* wg, const float* bgate, float* gates, const float* part, int nparts, float* xwb, int gw, int ngw, int lane) {
    f32x4 gA[4], gB[4];
#pragma unroll
    for (int j = 0; j < 4; ++j) { gA[j] = ((const f32x4*)g1)[lane + 64 * j]; gB[j] = o2 ? ((const f32x4*)g2)[lane + 64 * j] : (f32x4){0.f, 0.f, 0.f, 0.f}; }
    const float bg = (wg && lane < 8) ? bgate[lane] : 0.f;
    f32x4 nv[4];
    if (gw < MT) { const float* xr = (gw < MP) ? srcP + (size_t)gw * D : srcS + (size_t)(gw - MP) * D;
#pragma unroll
        for (int j = 0; j < 4; ++j) nv[j] = ((const f32x4*)xr)[lane + 64 * j]; }
    for (int m = gw; m < MT; m += ngw) {
        f32x4 v[4]; float s = 0.f;
#pragma unroll
        for (int j = 0; j < 4; ++j) { v[j] = nv[j]; s += (v[j].x * v[j].x + v[j].y * v[j].y) + (v[j].z * v[j].z + v[j].w * v[j].w); }
        { const int mn = m + ngw;
            if (mn < MT) { const float* xn = (mn < MP) ? srcP + (size_t)mn * D : srcS + (size_t)(mn - MP) * D;
#pragma unroll
                for (int j = 0; j < 4; ++j) nv[j] = ((const f32x4*)xn)[lane + 64 * j]; } }
        if (part && m >= MP) {
#pragma unroll 4
            for (int p = 0; p < nparts; ++p) { const f32x4* pr = (const f32x4*)(part + (size_t)p * 1048576 + (size_t)(m - MP) * D);
#pragma unroll
                for (int j = 0; j < 4; ++j) v[j] += pr[lane + 64 * j]; }
            s = 0.f;
#pragma unroll
            for (int j = 0; j < 4; ++j) { s += (v[j].x * v[j].x + v[j].y * v[j].y) + (v[j].z * v[j].z + v[j].w * v[j].w); if (xwb) ((f32x4*)(xwb + (size_t)m * D))[lane + 64 * j] = v[j]; }
        }
        const float rstd = 1.0f / sqrtf(wave_sum(s) * (1.0f / D) + EPS);
        if (xcopy) {
#pragma unroll
            for (int j = 0; j < 4; ++j) ((f32x4*)(xcopy + (size_t)m * D))[lane + 64 * j] = v[j];
        }
        float ga[8];
#pragma unroll
        for (int q = 0; q < 8; ++q) ga[q] = 0.f;
#pragma unroll
        for (int j = 0; j < 4; ++j) { const f32x4 g = gA[j]; const f32x4 y = v[j] * rstd * g;
            if (fout) ((f32x4*)(fout + (size_t)m * D))[lane + 64 * j] = y;
            else { u32x2 w; w.x = pk2(y.x, y.y); w.y = pk2(y.z, y.w); ((u32x2*)(o1 + (size_t)m * D))[lane + 64 * j] = w; }
            if (wg) {
#pragma unroll
                for (int e = 0; e < 4; ++e) { const int k = 4 * (lane + 64 * j) + e; const f32x4 w0 = *(const LAS f32x4*)(wg + k * 8), w1 = *(const LAS f32x4*)(wg + k * 8 + 4); const float ye = y[e];
                    ga[0] += ye * w0.x; ga[1] += ye * w0.y; ga[2] += ye * w0.z; ga[3] += ye * w0.w; ga[4] += ye * w1.x; ga[5] += ye * w1.y; ga[6] += ye * w1.z; ga[7] += ye * w1.w; }
            }
        }
        if (o2) {
#pragma unroll
            for (int j = 0; j < 4; ++j) { const f32x4 g = gB[j]; const f32x4 y = v[j] * rstd * g;
                u32x2 w; w.x = pk2(y.x, y.y); w.y = pk2(y.z, y.w); ((u32x2*)(o2 + (size_t)m * D))[lane + 64 * j] = w; }
        }
        if (wg) {
#pragma unroll
            for (int q = 0; q < 8; ++q) ga[q] = wave_sum(ga[q]);
            float gv = ga[0];
#pragma unroll
            for (int q = 1; q < 8; ++q) gv = (lane == q) ? ga[q] : gv;
            if (lane < 8) { gv += bg; gv = 15.0f * tanhf(gv * (1.0f / 15.0f)); if (lane >= 4) gv = -log1pf(expf(-gv)); gates[(size_t)m * 8 + lane] = gv; }
        }
    }
}

__device__ __forceinline__ void store16(bf16* bdst, float* fdst, const float (&x)[16]) {
    u32x4 w0, w1; w0.x = pk2(x[0], x[1]); w0.y = pk2(x[2], x[3]); w0.z = pk2(x[4], x[5]); w0.w = pk2(x[6], x[7]);
    w1.x = pk2(x[8], x[9]); w1.y = pk2(x[10], x[11]); w1.z = pk2(x[12], x[13]); w1.w = pk2(x[14], x[15]);
    ((u32x4*)bdst)[0] = w0; ((u32x4*)bdst)[1] = w1;
    if (fdst) {
#pragma unroll
        for (int q = 0; q < 4; ++q) ((f32x4*)fdst)[q] = (f32x4){x[4 * q], x[4 * q + 1], x[4 * q + 2], x[4 * q + 3]};
    }
}
__device__ __forceinline__ void kv_finalize(ArgsP a, int gtid, int ngt) {
    unsigned char* ws = a->ws;
    const float* kvraw = (const float*)(ws + WS_KVRAW);
    bf16* KB = (bf16*)(ws + WS_KB); bf16* VB = (bf16*)(ws + WS_VB); bf16* SKB = (bf16*)(ws + WS_SKB); bf16* SVB = (bf16*)(ws + WS_SVB);
    float* out = a->out;
    for (int it = gtid; it < MT * 32; it += ngt) {
        const int part = it & 7, kvh = (it >> 3) & 3, m = it >> 5; const int isv = part >> 2, p = part & 3;
        const float* src = kvraw + (size_t)m * 512 + isv * 256 + kvh * 64 + p * 16;
        float x[16];
#pragma unroll
        for (int q = 0; q < 4; ++q) { const f32x4 t = ((const f32x4*)src)[q]; x[4 * q] = t.x; x[4 * q + 1] = t.y; x[4 * q + 2] = t.z; x[4 * q + 3] = t.w; }
        if (part == 0) {
            const int pos = (m < MP) ? (m & 8191) : 8192 + ((m - MP) & 7);
            const float* rt = (const float*)(ws + WS_ROPE) + (size_t)pos * 16;
            const f32x4 c0 = *(const f32x4*)rt, c1 = *(const f32x4*)(rt + 4), s0 = *(const f32x4*)(rt + 8), s1 = *(const f32x4*)(rt + 12);
            const float cs[8] = {c0.x, c0.y, c0.z, c0.w, c1.x, c1.y, c1.z, c1.w}, sn[8] = {s0.x, s0.y, s0.z, s0.w, s1.x, s1.y, s1.z, s1.w};
#pragma unroll
            for (int i = 0; i < 8; ++i) { const float c = cs[i], s = sn[i]; const float x1 = x[i], x2 = x[8 + i]; x[i] = x1 * c - x2 * s; x[8 + i] = x2 * c + x1 * s; }
        }
        bf16* bdst; float* fdst = nullptr;
        if (m < MP) { const int b = m >> 13, t = m & 8191; bdst = (isv ? VB : KB) + (size_t)m * 256 + kvh * 64 + p * 16;
            if (t >= 8192 - 128) fdst = out + (isv ? OFF_PV : OFF_PK) + ((size_t)(b * 128 + t - 8064) * 4 + kvh) * 64 + p * 16; }
        else { const int ms = m - MP, b = ms >> 3, t = ms & 7; bdst = (isv ? SVB : SKB) + (size_t)(b * 136 + 128 + t) * 256 + kvh * 64 + p * 16;
            fdst = out + (isv ? OFF_SV : OFF_SK) + ((size_t)(b * 128 + 120 + t) * 4 + kvh) * 64 + p * 16; }
        store16(bdst, fdst, x);
    }
    for (int it = gtid; it < 128 * 128 * 32; it += ngt) {
        const int part = it & 7, kvh = (it >> 3) & 3, i = (it >> 5) & 127, b = it >> 12; const int isv = part >> 2, p = part & 3;
        const float* src = (isv ? a->in[6] : a->in[5]) + ((size_t)(b * 128 + i) * 4 + kvh) * 64 + p * 16;
        float x[16];
#pragma unroll
        for (int q = 0; q < 4; ++q) { const f32x4 t = ((const f32x4*)src)[q]; x[4 * q] = t.x; x[4 * q + 1] = t.y; x[4 * q + 2] = t.z; x[4 * q + 3] = t.w; }
        bf16* bdst = (isv ? SVB : SKB) + (size_t)(b * 136 + i) * 256 + kvh * 64 + p * 16;
        float* fdst = (i >= 8) ? out + (isv ? OFF_SV : OFF_SK) + ((size_t)(b * 128 + i - 8) * 4 + kvh) * 64 + p * 16 : nullptr;
        store16(bdst, fdst, x);
    }
}

template <bool SAMPLE>
__device__ __forceinline__ void attn_rowmap(int wt, int q, int b, int kvh, int j, int& head, int& grow, int& qpos) {
    if (!SAMPLE) { head = kvh * 4 + (wt >> 3); const int rib = (wt & 7) * 16 + q; grow = b * 8192 + j * 128 + rib; qpos = j * 128 + rib; }
    else { head = kvh * 4 + 2 * wt + (q >> 3); const int t = q & 7; grow = MP + b * 8 + t; qpos = 8192 + t; }
}
template <int NKT, bool SAMPLE>
__device__ __forceinline__ void attn_units(const bf16* Q, const bf16* KBp, const bf16* VBp, bf16* O, const float* sinks, const float* rope, const float* qpart, LAS unsigned char* lds, int tid, int wave, int lane, int bid, int nb) {
    constexpr int NK = 16 * NKT, KSTR = 72, VSTR = NK + 8;
    LAS bf16* Ks = (LAS bf16*)lds; LAS bf16* VT = (LAS bf16*)(lds + 256 * KSTR * 2);
    const int l15 = lane & 15, g = lane >> 4;
    for (int u = bid; u < 512; u += nb) {
        int b, kvh, j = 0, nkeys, kbase; const bf16 *ksrc, *vsrc;
        if (!SAMPLE) { kvh = u & 3; j = (u >> 2) & 63; b = u >> 8; kbase = (j - 1) * 128; nkeys = 256;
            ksrc = KBp + ((ptrdiff_t)b * 8192 + kbase) * 256 + kvh * 64; vsrc = VBp + ((ptrdiff_t)b * 8192 + kbase) * 256 + kvh * 64; }
        else { kvh = u & 3; b = u >> 2; kbase = 8192 - 128; nkeys = 136; ksrc = KBp + (ptrdiff_t)b * 136 * 256 + kvh * 64; vsrc = VBp + (ptrdiff_t)b * 136 * 256 + kvh * 64; }
        __syncthreads();
        constexpr int NST = (NK * 8 + NTHR - 1) / NTHR; u32x4 kst[NST], vst[NST];
#pragma unroll
        for (int i = 0; i < NST; ++i) { const int c = tid + i * NTHR, key = c >> 3, cc = c & 7; const bool valid = (c < NK * 8) && (key < nkeys) && (kbase + key >= 0);
            kst[i] = (u32x4){0u, 0u, 0u, 0u}; vst[i] = (u32x4){0u, 0u, 0u, 0u};
            if (valid) { kst[i] = *(const u32x4*)(ksrc + (ptrdiff_t)key * 256 + cc * 8); vst[i] = *(const u32x4*)(vsrc + (ptrdiff_t)key * 256 + cc * 8); } }
#pragma unroll
        for (int i = 0; i < NST; ++i) { const int c = tid + i * NTHR, key = c >> 3, cc = c & 7;
            if (c < NK * 8) { *(LAS u32x4*)(Ks + key * KSTR + cc * 8) = kst[i]; const u32x4 vv = vst[i];
#pragma unroll
                for (int e = 0; e < 4; ++e) { VT[(cc * 8 + 2 * e) * VSTR + key] = (bf16)(vv[e] & 0xffffu); VT[(cc * 8 + 2 * e + 1) * VSTR + key] = (bf16)(vv[e] >> 16); } } }
        __syncthreads();
        const int ntile = SAMPLE ? 2 : 32;
        for (int wt = wave; wt < ntile; wt += 8) {
            int head, grow, qpos; attn_rowmap<SAMPLE>(wt, l15, b, kvh, j, head, grow, qpos);
            u32x4 q0, q1;
            if (!SAMPLE) { const bf16* qp = Q + (size_t)grow * D + head * 64 + 8 * g; q0 = *(const u32x4*)qp; q1 = *(const u32x4*)(qp + 32); }
            else {
                const float* pp = qpart + (size_t)(grow - MP) * D + head * 64 + 8 * g; f32x4 a0 = (f32x4){0.f, 0.f, 0.f, 0.f}, a1 = a0, b0 = a0, b1 = a0;
#pragma unroll
                for (int p = 0; p < 4; ++p) { const float* q4 = pp + (size_t)p * 1048576; a0 += *(const f32x4*)q4; a1 += *(const f32x4*)(q4 + 4); b0 += *(const f32x4*)(q4 + 32); b1 += *(const f32x4*)(q4 + 36); }
                q0.x = pk2(a0.x, a0.y); q0.y = pk2(a0.z, a0.w); q0.z = pk2(a1.x, a1.y); q0.w = pk2(a1.z, a1.w);
                q1.x = pk2(b0.x, b0.y); q1.y = pk2(b0.z, b0.w); q1.z = pk2(b1.x, b1.y); q1.w = pk2(b1.z, b1.w); }
            {
                u32x4 oth; oth.x = __shfl_xor(q0.x, 16); oth.y = __shfl_xor(q0.y, 16); oth.z = __shfl_xor(q0.z, 16); oth.w = __shfl_xor(q0.w, 16);
                if (g < 2) { const float sg = (g == 0) ? -1.0f : 1.0f; u32x4 r; const float* rt = rope + (size_t)qpos * 16;
                    const f32x4 c0 = *(const f32x4*)rt, c1 = *(const f32x4*)(rt + 4), s0 = *(const f32x4*)(rt + 8), s1 = *(const f32x4*)(rt + 12);
                    const float cs[8] = {c0.x, c0.y, c0.z, c0.w, c1.x, c1.y, c1.z, c1.w}, sn[8] = {s0.x, s0.y, s0.z, s0.w, s1.x, s1.y, s1.z, s1.w};
#pragma unroll
                    for (int e = 0; e < 4; ++e) { const float a0 = bflo(q0[e]) * cs[2 * e] + sg * bflo(oth[e]) * sn[2 * e], a1 = bfhi(q0[e]) * cs[2 * e + 1] + sg * bfhi(oth[e]) * sn[2 * e + 1]; r[e] = pk2(a0, a1); }
                    q0 = r; }
            }
            const bf16x8 qf0 = __builtin_bit_cast(bf16x8, q0), qf1 = __builtin_bit_cast(bf16x8, q1);
            const int lo = max(max(qpos - 127 - kbase, -kbase), 0), hi = min(qpos - kbase, nkeys - 1); const unsigned span = (unsigned)(hi - lo);
            const int ks_lo = SAMPLE ? 0 : ((wt & 7) >> 1), ks_hi = SAMPLE ? (NKT / 2 - 1) : (((wt & 7) + 8) >> 1);
            float mx = -INFINITY;
#pragma unroll 2
            for (int kt = 2 * ks_lo; kt <= 2 * ks_hi + 1; ++kt) { f32x4 acc = (f32x4){0.f, 0.f, 0.f, 0.f};
                const LAS bf16* kp = Ks + (16 * kt + l15) * KSTR + 8 * g;
                acc = mfma16(*(const LAS bf16x8*)kp, qf0, acc); acc = mfma16(*(const LAS bf16x8*)(kp + 32), qf1, acc);
#pragma unroll
                for (int r = 0; r < 4; ++r) { const int i = 16 * kt + 4 * g + r; const bool valid = (unsigned)(i - lo) <= span; mx = fmaxf(mx, valid ? acc[r] * 0.125f : -INFINITY); } }
            mx = fmaxf(mx, __shfl_xor(mx, 16)); mx = fmaxf(mx, __shfl_xor(mx, 32));
            const float sk = sinks[head]; mx = fmaxf(mx, sk);
            float sum = 0.f;
            f32x4 oacc[4];
#pragma unroll
            for (int nt = 0; nt < 4; ++nt) oacc[nt] = (f32x4){0.f, 0.f, 0.f, 0.f};
#pragma unroll 1
            for (int ks = ks_lo; ks <= ks_hi; ++ks) { float p[2][4];
#pragma unroll
                for (int hh = 0; hh < 2; ++hh) { const int kt = 2 * ks + hh; f32x4 acc = (f32x4){0.f, 0.f, 0.f, 0.f};
                    const LAS bf16* kp = Ks + (16 * kt + l15) * KSTR + 8 * g;
                    acc = mfma16(*(const LAS bf16x8*)kp, qf0, acc); acc = mfma16(*(const LAS bf16x8*)(kp + 32), qf1, acc);
#pragma unroll
                    for (int r = 0; r < 4; ++r) { const int i = 16 * kt + 4 * g + r; const bool valid = (unsigned)(i - lo) <= span; const float pv = valid ? __expf(acc[r] * 0.125f - mx) : 0.f; p[hh][r] = pv; sum += pv; } }
                u32x4 pw; pw.x = pk2(p[0][0], p[0][1]); pw.y = pk2(p[0][2], p[0][3]); pw.z = pk2(p[1][0], p[1][1]); pw.w = pk2(p[1][2], p[1][3]);
                const bf16x8 pa = __builtin_bit_cast(bf16x8, pw);
#pragma unroll
                for (int nt = 0; nt < 4; ++nt) { const LAS bf16* vp = VT + (16 * nt + l15) * VSTR + 32 * ks + 4 * g; const u32x2 lo = *(const LAS u32x2*)vp, hi = *(const LAS u32x2*)(vp + 16);
                    const u32x4 vw = (u32x4){lo.x, lo.y, hi.x, hi.y}; oacc[nt] = mfma16(pa, __builtin_bit_cast(bf16x8, vw), oacc[nt]); } }
            sum += __shfl_xor(sum, 16); sum += __shfl_xor(sum, 32);
            const float inv = 1.0f / (sum + __expf(sk - mx));
#pragma unroll
            for (int r = 0; r < 4; ++r) { const int qq = 4 * g + r; const float ir = __shfl(inv, qq); int h2, gr2, qp2; attn_rowmap<SAMPLE>(wt, qq, b, kvh, j, h2, gr2, qp2);
                bf16* op = O + (size_t)gr2 * D + h2 * 64 + l15;
#pragma unroll
                for (int nt = 0; nt < 4; ++nt) op[16 * nt] = (bf16)f2bf(oacc[nt][r] * ir); }
        }
    }
}

__device__ __forceinline__ void mlstm_a_units(const bf16* PROJ, const float* GATES, float* DCT, float* DN, float* AB, LAS unsigned char* lds, int tid, int wave, int lane, int bid, int nb) {
    LAS bf16* KT = (LAS bf16*)lds;
    LAS bf16* AVT = (LAS bf16*)(lds + 18432);
    LAS float* av = (LAS float*)(lds + 18432 + 36864);
    const int l15 = lane & 15, g = lane >> 4;
    for (int u = bid; u < 1024; u += nb) {
        const int bh = u >> 7, c = u & 127, b = bh >> 2, h = bh & 3; const int row0 = b * 8192 + c * 64;
        __syncthreads();
        u32x4 kreg[2], vreg[4];
#pragma unroll
        for (int i = 0; i < 2; ++i) { const int ci = tid + i * NTHR, s = ci >> 4, cc = ci & 15; kreg[i] = *(const u32x4*)(PROJ + (size_t)(row0 + s) * NPROJ + 512 + h * 128 + cc * 8); }
#pragma unroll
        for (int i = 0; i < 4; ++i) { const int ci = tid + i * NTHR, s = ci >> 5, cc = ci & 31; vreg[i] = *(const u32x4*)(PROJ + (size_t)(row0 + s) * NPROJ + 1024 + h * 256 + cc * 8); }
        if (wave == 0) { const float lf = GATES[(size_t)(row0 + lane) * 8 + 4 + h], ig = GATES[(size_t)(row0 + lane) * 8 + h];
            float bs = lf;
#pragma unroll
            for (int o = 1; o < 64; o <<= 1) { const float t = __shfl_up(bs, o); if (lane >= o) bs += t; }
            const float B = __shfl(bs, 63); const float e = B - bs + ig; const float A = wave_max(e);
            av[lane] = __expf(e - A) * KSCALE; if (lane == 0) { AB[u * 2] = A; AB[u * 2 + 1] = B; } }
        __syncthreads();
#pragma unroll
        for (int i = 0; i < 2; ++i) { const int ci = tid + i * NTHR, s = ci >> 4, cc = ci & 15; const u32x4 kv = kreg[i];
#pragma unroll
            for (int e = 0; e < 4; ++e) { KT[(cc * 8 + 2 * e) * 72 + s] = (bf16)(kv[e] & 0xffffu); KT[(cc * 8 + 2 * e + 1) * 72 + s] = (bf16)(kv[e] >> 16); } }
#pragma unroll
        for (int i = 0; i < 4; ++i) { const int ci = tid + i * NTHR, s = ci >> 5, cc = ci & 31; const u32x4 vv = vreg[i]; const float as = av[s];
#pragma unroll
            for (int e = 0; e < 4; ++e) { AVT[(cc * 8 + 2 * e) * 72 + s] = (bf16)f2bf(bflo(vv[e]) * as); AVT[(cc * 8 + 2 * e + 1) * 72 + s] = (bf16)f2bf(bfhi(vv[e]) * as); } }
        __syncthreads();
        if (wave == 7) {
            u32x4 w0 = (u32x4){0u, 0u, 0u, 0u}, w1 = (u32x4){0u, 0u, 0u, 0u};
            if (l15 == 0) { const LAS float* ap0 = av + 8 * g; const LAS float* ap1 = av + 32 + 8 * g;
                w0.x = pk2(ap0[0], ap0[1]); w0.y = pk2(ap0[2], ap0[3]); w0.z = pk2(ap0[4], ap0[5]); w0.w = pk2(ap0[6], ap0[7]);
                w1.x = pk2(ap1[0], ap1[1]); w1.y = pk2(ap1[2], ap1[3]); w1.z = pk2(ap1[4], ap1[5]); w1.w = pk2(ap1[6], ap1[7]); }
            const bf16x8 a0 = __builtin_bit_cast(bf16x8, w0), a1 = __builtin_bit_cast(bf16x8, w1);
#pragma unroll
            for (int nt = 0; nt < 8; ++nt) { f32x4 acc = (f32x4){0.f, 0.f, 0.f, 0.f};
                acc = mfma16(a0, *(const LAS bf16x8*)(KT + (16 * nt + l15) * 72 + 8 * g), acc); acc = mfma16(a1, *(const LAS bf16x8*)(KT + (16 * nt + l15) * 72 + 32 + 8 * g), acc);
                if (g == 0) DN[(size_t)u * 128 + 16 * nt + l15] = acc[0]; } }
#pragma unroll
        for (int mi = 0; mi < 2; ++mi) { const int mt = 2 * wave + mi;
            const bf16x8 a0 = *(const LAS bf16x8*)(AVT + (16 * mt + l15) * 72 + 8 * g), a1 = *(const LAS bf16x8*)(AVT + (16 * mt + l15) * 72 + 32 + 8 * g);
#pragma unroll
            for (int nt = 0; nt < 8; ++nt) { f32x4 acc = (f32x4){0.f, 0.f, 0.f, 0.f};
                acc = mfma16(*(const LAS bf16x8*)(KT + (16 * nt + l15) * 72 + 8 * g), a0, acc); acc = mfma16(*(const LAS bf16x8*)(KT + (16 * nt + l15) * 72 + 32 + 8 * g), a1, acc);
                *(f32x4*)(DCT + (size_t)u * 32768 + (16 * mt + l15) * 128 + 16 * nt + 4 * g) = acc; } }
    }
}
__device__ __forceinline__ void mlstm_b(const float* DCT, const float* DN, const float* AB, bf16* CTS, float* NS, float* MSb, float* oC, float* oN, float* oM, int gtid, int ngt) {
    for (int it = gtid; it < 131072; it += ngt) { const int dp = it & 63, v = (it >> 6) & 255, bh = it >> 14;
        float m = 0.f, c0 = 0.f, c1 = 0.f;
        const float* dsrc = DCT + (size_t)bh * 128 * 32768 + v * 128 + 2 * dp; bf16* cdst = CTS + (size_t)bh * 128 * 32768 + v * 128 + 2 * dp; const float* ab = AB + bh * 256;
        for (int c = 0; c < 128; c += 16) { f32x2v d[16], abv[16];
#pragma unroll
            for (int i = 0; i < 16; ++i) { d[i] = *(const f32x2v*)(dsrc + (size_t)(c + i) * 32768); abv[i] = *(const f32x2v*)(ab + (c + i) * 2); }
#pragma unroll
            for (int i = 0; i < 16; ++i) { const float A = abv[i].x, B = abv[i].y; *(unsigned*)(cdst + (size_t)(c + i) * 32768) = pk2(c0, c1);
                const float mn = fmaxf(B + m, A); const float dec = __expf(B + m - mn), inj = __expf(A - mn); c0 = dec * c0 + inj * d[i].x; c1 = dec * c1 + inj * d[i].y; m = mn; } }
        oC[((size_t)bh * 128 + 2 * dp) * 256 + v] = c0; oC[((size_t)bh * 128 + 2 * dp + 1) * 256 + v] = c1; }
    for (int it = gtid; it < 1024; it += ngt) { const int d = it & 127, bh = it >> 7; float m = 0.f, n = 0.f; const float* ab = AB + bh * 256;
        for (int c0 = 0; c0 < 128; c0 += 16) { float dn[16]; f32x2v abv[16];
#pragma unroll
            for (int i = 0; i < 16; ++i) { dn[i] = DN[(size_t)(bh * 128 + c0 + i) * 128 + d]; abv[i] = *(const f32x2v*)(ab + (c0 + i) * 2); }
#pragma unroll
            for (int i = 0; i < 16; ++i) { const int c = c0 + i; NS[(size_t)(bh * 129 + c) * 128 + d] = n; if (d == 0) MSb[bh * 129 + c] = m; const float A = abv[i].x, B = abv[i].y;
                const float mn = fmaxf(B + m, A); const float dec = __expf(B + m - mn), inj = __expf(A - mn); n = dec * n + inj * dn[i]; m = mn; } }
        oN[bh * 128 + d] = n; if (d == 0) oM[bh] = m; }
}
__device__ __forceinline__ void mlstm_c_units(const bf16* PROJ, const float* GATES, const bf16* CTS, const float* NS, const float* MSb, const float* hnorm, bf16* HH, LAS unsigned char* lds, int tid, int wave, int lane, int bid, int nb) {
    LAS bf16* Qs = (LAS bf16*)lds;
    LAS bf16* Ks = (LAS bf16*)(lds + 17408);
    LAS bf16* VT = (LAS bf16*)(lds + 34816);
    LAS bf16* Ps = (LAS bf16*)(lds + 71680);
    LAS float* sc = (LAS float*)(lds + 80896);
    LAS float *s_u = sc, *s_M = sc + 64, *s_w = sc + 128, *s_e = sc + 192, *s_dens = sc + 256, *s_qn = sc + 320, *s_ss = sc + 384, *s_rden = sc + 448;
    const int l15 = lane & 15, g = lane >> 4;
    for (int u = bid; u < 1024; u += nb) {
        const int bh = u >> 7, c = u & 127, b = bh >> 2, h = bh & 3; const int row0 = b * 8192 + c * 64;
        __syncthreads();
        u32x4 qreg[2], kreg[2], vreg[4];
#pragma unroll
        for (int i = 0; i < 2; ++i) { const int ci = tid + i * NTHR, s = ci >> 4, cc = ci & 15; const bf16* rp = PROJ + (size_t)(row0 + s) * NPROJ + h * 128 + cc * 8; qreg[i] = *(const u32x4*)rp; kreg[i] = *(const u32x4*)(rp + 512); }
#pragma unroll
        for (int i = 0; i < 4; ++i) { const int ci = tid + i * NTHR, s = ci >> 5, cc = ci & 31; vreg[i] = *(const u32x4*)(PROJ + (size_t)(row0 + s) * NPROJ + 1024 + h * 256 + cc * 8); }
        if (wave == 0) { const float lf = GATES[(size_t)(row0 + lane) * 8 + 4 + h], ig = GATES[(size_t)(row0 + lane) * 8 + h];
            float bs = lf;
#pragma unroll
            for (int o = 1; o < 64; o <<= 1) { const float t = __shfl_up(bs, o); if (lane >= o) bs += t; }
            const float uu = ig - bs; float U = uu;
#pragma unroll
            for (int o = 1; o < 64; o <<= 1) { const float t = __shfl_up(U, o); if (lane >= o) U = fmaxf(U, t); }
            const float mc = MSb[bh * 129 + c]; const float Mt = fmaxf(mc, U);
            s_u[lane] = uu; s_M[lane] = Mt; s_w[lane] = __expf(mc - Mt); s_e[lane] = __expf(-(bs + Mt)); s_dens[lane] = 0.f; s_ss[lane] = 0.f; }
#pragma unroll
        for (int i = 0; i < 2; ++i) { const int ci = tid + i * NTHR, s = ci >> 4, cc = ci & 15; *(LAS u32x4*)(Qs + s * 136 + cc * 8) = qreg[i]; *(LAS u32x4*)(Ks + s * 136 + cc * 8) = kreg[i]; }
#pragma unroll
        for (int i = 0; i < 4; ++i) { const int ci = tid + i * NTHR, s = ci >> 5, cc = ci & 31; const u32x4 vv = vreg[i];
#pragma unroll
            for (int e = 0; e < 4; ++e) { VT[(cc * 8 + 2 * e) * 72 + s] = (bf16)(vv[e] & 0xffffu); VT[(cc * 8 + 2 * e + 1) * 72 + s] = (bf16)(vv[e] >> 16); } }
        f32x4 hnv[2];
#pragma unroll
        for (int nl = 0; nl < 2; ++nl) hnv[nl] = *(const f32x4*)(hnorm + h * 256 + 16 * (2 * wave + nl) + 4 * g);
        u32x2 og[4][2];
#pragma unroll
        for (int mt = 0; mt < 4; ++mt)
#pragma unroll
            for (int nl = 0; nl < 2; ++nl) og[mt][nl] = *(const u32x2*)(PROJ + (size_t)(row0 + 16 * mt + l15) * NPROJ + 2048 + h * 256 + 16 * (2 * wave + nl) + 4 * g);
        __syncthreads();
#pragma unroll
        for (int ti2 = 0; ti2 < 2; ++ti2) { const int tile = 2 * wave + ti2, ti = tile >> 2, si = tile & 3;
            f32x4 acc = (f32x4){0.f, 0.f, 0.f, 0.f};
            if (si <= ti) {
#pragma unroll
                for (int ks = 0; ks < 4; ++ks) acc = mfma16(*(const LAS bf16x8*)(Qs + (16 * ti + l15) * 136 + 32 * ks + 8 * g), *(const LAS bf16x8*)(Ks + (16 * si + l15) * 136 + 32 * ks + 8 * g), acc); }
            const int s = 16 * si + l15; const float us = s_u[s];
#pragma unroll
            for (int r = 0; r < 4; ++r) { const int t = 16 * ti + 4 * g + r; float p = (s <= t) ? acc[r] * KSCALE * __expf(us - s_M[t]) : 0.f;
                Ps[t * 72 + s] = (bf16)f2bf(p);
                p += __shfl_xor(p, 1); p += __shfl_xor(p, 2); p += __shfl_xor(p, 4); p += __shfl_xor(p, 8);
                if (l15 == 0) __hip_atomic_fetch_add(s_dens + t, p, __ATOMIC_RELAXED, __HIP_MEMORY_SCOPE_WORKGROUP); } }
        {   const int t = tid >> 3, part = tid & 7; float acc = 0.f; const float* np = NS + (size_t)(bh * 129 + c) * 128 + part * 16;
#pragma unroll
            for (int dd = 0; dd < 16; ++dd) acc += bf2f(Qs[t * 136 + part * 16 + dd]) * np[dd];
            acc += __shfl_xor(acc, 1); acc += __shfl_xor(acc, 2); acc += __shfl_xor(acc, 4);
            if (part == 0) s_qn[t] = acc; }
        __syncthreads();
        if (tid < 64) { const float den = s_dens[tid] + s_w[tid] * s_qn[tid]; s_rden[tid] = 1.0f / fmaxf(fabsf(den), s_e[tid]); }
        __syncthreads();
        f32x4 a1[4][2];
#pragma unroll
        for (int nl = 0; nl < 2; ++nl) { const int nt = 2 * wave + nl; f32x4 acc[4];
#pragma unroll
            for (int mt = 0; mt < 4; ++mt) acc[mt] = (f32x4){0.f, 0.f, 0.f, 0.f};
            const bf16* cp = CTS + ((size_t)u * 256 + 16 * nt + l15) * 128 + 8 * g;
#pragma unroll
            for (int ks = 0; ks < 4; ++ks) { const bf16x8 afr = *(const bf16x8*)(cp + 32 * ks);
#pragma unroll
                for (int mt = 0; mt < 4; ++mt) acc[mt] = mfma16(afr, *(const LAS bf16x8*)(Qs + (16 * mt + l15) * 136 + 32 * ks + 8 * g), acc[mt]); }
#pragma unroll
            for (int mt = 0; mt < 4; ++mt) acc[mt] *= s_w[16 * mt + l15];
#pragma unroll
            for (int ks = 0; ks < 2; ++ks) { const bf16x8 afr = *(const LAS bf16x8*)(VT + (16 * nt + l15) * 72 + 32 * ks + 8 * g);
#pragma unroll
                for (int mt = 0; mt < 4; ++mt) acc[mt] = mfma16(afr, *(const LAS bf16x8*)(Ps + (16 * mt + l15) * 72 + 32 * ks + 8 * g), acc[mt]); }
#pragma unroll
            for (int mt = 0; mt < 4; ++mt) a1[mt][nl] = acc[mt] * s_rden[16 * mt + l15];
            asm volatile("" ::: "memory"); }
#pragma unroll
        for (int mt = 0; mt < 4; ++mt) { const int t = 16 * mt + l15; float q = 0.f;
#pragma unroll
            for (int nl = 0; nl < 2; ++nl) { const f32x4 hv = a1[mt][nl]; q += (hv[0] * hv[0] + hv[1] * hv[1]) + (hv[2] * hv[2] + hv[3] * hv[3]); }
            q += __shfl_xor(q, 16); q += __shfl_xor(q, 32);
            if (g == 0) __hip_atomic_fetch_add(s_ss + t, q, __ATOMIC_RELAXED, __HIP_MEMORY_SCOPE_WORKGROUP); }
        __syncthreads();
#pragma unroll
        for (int mt = 0; mt < 4; ++mt) { const int t = 16 * mt + l15; const float rs = 1.0f / sqrtf(s_ss[t] * (1.0f / 256.0f) + EPS);
#pragma unroll
            for (int nl = 0; nl < 2; ++nl) { const int v0 = 16 * (2 * wave + nl) + 4 * g; const u32x2 ow = og[mt][nl]; const f32x4 hn = hnv[nl]; const f32x4 hv = a1[mt][nl];
                const float o0 = bflo(ow.x), o1 = bfhi(ow.x), o2 = bflo(ow.y), o3 = bfhi(ow.y);
                u32x2 w; w.x = pk2(hv[0] * rs * hn[0] / (1.0f + __expf(-o0)), hv[1] * rs * hn[1] / (1.0f + __expf(-o1))); w.y = pk2(hv[2] * rs * hn[2] / (1.0f + __expf(-o2)), hv[3] * rs * hn[3] / (1.0f + __expf(-o3)));
                *(u32x2*)(HH + (size_t)(row0 + t) * D + h * 256 + v0) = w; } }
    }
}
__device__ __forceinline__ void mlstm_sample_units(const bf16* PROJ, const float* GATES, const float* C0, const float* n0, const float* m0, const float* hnorm, bf16* HH,
                                                   float* oC, float* oN, float* oM, LAS unsigned char* lds, int tid, int wave, int lane, int bid, int nb) {
    LAS float* q = (LAS float*)lds;
    LAS float* k = q + 1024;
    LAS float* vv = k + 1024;
    LAS float* part = vv + 2048;
    LAS float* sc = part + 16384;
    LAS float *s_S = sc, *s_u = sc + 64, *s_M = sc + 72, *s_w = sc + 80, *s_e = sc + 88, *s_a = sc + 96, *s_qn = sc + 104, *s_ss = sc + 112, *s_rden = sc + 120, *s_misc = sc + 128;
    for (int u = bid; u < 512; u += nb) {
        const int b = u >> 2, h = u & 3; const int row0 = MP + b * 8; const int bh = b * 4 + h;
        __syncthreads();
        if (tid < 128) { const int t = tid >> 4, cc = tid & 15; const u32x4 w = *(const u32x4*)(PROJ + (size_t)(row0 + t) * NPROJ + h * 128 + cc * 8);
#pragma unroll
            for (int e = 0; e < 4; ++e) { q[t * 128 + cc * 8 + 2 * e] = bflo(w[e]); q[t * 128 + cc * 8 + 2 * e + 1] = bfhi(w[e]); } }
        else if (tid < 256) { const int i = tid - 128, t = i >> 4, cc = i & 15; const u32x4 w = *(const u32x4*)(PROJ + (size_t)(row0 + t) * NPROJ + 512 + h * 128 + cc * 8);
#pragma unroll
            for (int e = 0; e < 4; ++e) { k[t * 128 + cc * 8 + 2 * e] = bflo(w[e]) * KSCALE; k[t * 128 + cc * 8 + 2 * e + 1] = bfhi(w[e]) * KSCALE; } }
        else { const int i = tid - 256, t = i >> 5, cc = i & 31; const u32x4 w = *(const u32x4*)(PROJ + (size_t)(row0 + t) * NPROJ + 1024 + h * 256 + cc * 8);
#pragma unroll
            for (int e = 0; e < 4; ++e) { vv[t * 256 + cc * 8 + 2 * e] = bflo(w[e]); vv[t * 256 + cc * 8 + 2 * e + 1] = bfhi(w[e]); } }
        if (tid == 0) { float bs[8], ig[8]; float run = 0.f;
#pragma unroll
            for (int t = 0; t < 8; ++t) { run += GATES[(size_t)(row0 + t) * 8 + 4 + h]; bs[t] = run; ig[t] = GATES[(size_t)(row0 + t) * 8 + h]; }
            const float m0v = m0[bh]; const float B = bs[7]; float A = -INFINITY;
#pragma unroll
            for (int t = 0; t < 8; ++t) A = fmaxf(A, B - bs[t] + ig[t]);
            const float mnew = fmaxf(B + m0v, A); float U = -INFINITY;
#pragma unroll
            for (int t = 0; t < 8; ++t) { const float uu = ig[t] - bs[t]; U = fmaxf(U, uu); const float Mt = fmaxf(m0v, U);
                s_u[t] = uu; s_M[t] = Mt; s_w[t] = __expf(m0v - Mt); s_e[t] = __expf(-(bs[t] + Mt)); s_a[t] = __expf(B - bs[t] + ig[t] - mnew); s_ss[t] = 0.f; }
            s_misc[0] = __expf(B + m0v - mnew); oM[bh] = mnew; }
        __syncthreads();
        const float decay = s_misc[0];
        if (tid < 64) { const int t = tid >> 3, s = tid & 7; float dot = 0.f;
            for (int d = 0; d < 128; ++d) dot += q[t * 128 + d] * k[s * 128 + d];
            s_S[t * 8 + s] = (s <= t) ? dot * __expf(s_u[s] - s_M[t]) : 0.f; }
        else if (tid < 72) { const int t = tid - 64; float dot = 0.f;
            for (int d = 0; d < 128; ++d) dot += q[t * 128 + d] * n0[(size_t)bh * 128 + d];
            s_qn[t] = dot; }
        else if (tid >= 128 && tid < 256) { const int d = tid - 128; float nn = decay * n0[(size_t)bh * 128 + d];
#pragma unroll
            for (int s = 0; s < 8; ++s) nn += s_a[s] * k[s * 128 + d];
            oN[(size_t)bh * 128 + d] = nn; }
        __syncthreads();
        if (tid < 8) { float den = s_w[tid] * s_qn[tid];
#pragma unroll
            for (int s = 0; s < 8; ++s) den += s_S[tid * 8 + s];
            s_rden[tid] = 1.0f / fmaxf(fabsf(den), s_e[tid]); }
        {
            const int v0 = 4 * (tid & 63), dg = tid >> 6; f32x4 acc[8], vr[8];
#pragma unroll
            for (int s = 0; s < 8; ++s) { acc[s] = (f32x4){0.f, 0.f, 0.f, 0.f}; vr[s] = *(const LAS f32x4*)(vv + s * 256 + v0) * s_a[s]; }
            const float* cp = C0 + ((size_t)bh * 128 + dg * 16) * 256 + v0; float* op = oC + ((size_t)bh * 128 + dg * 16) * 256 + v0;
#pragma unroll 4
            for (int dd = 0; dd < 16; ++dd) { const int d = dg * 16 + dd; const f32x4 cv = *(const f32x4*)(cp + (size_t)dd * 256); f32x4 cn = cv * decay;
#pragma unroll
                for (int s = 0; s < 8; ++s) { acc[s] += cv * q[s * 128 + d]; cn += vr[s] * k[s * 128 + d]; }
                *(f32x4*)(op + (size_t)dd * 256) = cn; }
#pragma unroll
            for (int t = 0; t < 8; ++t) *(LAS f32x4*)(part + (dg * 8 + t) * 256 + v0) = acc[t]; }
        __syncthreads();
        {   const int v = tid & 255, th = tid >> 8; float hv[4];
#pragma unroll
            for (int tt = 0; tt < 4; ++tt) { const int t = th * 4 + tt; float ps = 0.f;
#pragma unroll
                for (int dg = 0; dg < 8; ++dg) ps += part[(dg * 8 + t) * 256 + v];
                float num = s_w[t] * ps;
#pragma unroll
                for (int s = 0; s < 8; ++s) num += s_S[t * 8 + s] * vv[s * 256 + v];
                hv[tt] = num * s_rden[t]; const float qv = wave_sum(hv[tt] * hv[tt]);
                if (lane == 0) __hip_atomic_fetch_add(s_ss + t, qv, __ATOMIC_RELAXED, __HIP_MEMORY_SCOPE_WORKGROUP); }
            __syncthreads();
#pragma unroll
            for (int tt = 0; tt < 4; ++tt) { const int t = th * 4 + tt; const float rs = 1.0f / sqrtf(s_ss[t] * (1.0f / 256.0f) + EPS);
                const float o = bf2f(PROJ[(size_t)(row0 + t) * NPROJ + 2048 + h * 256 + v]);
                HH[(size_t)(row0 + t) * D + h * 256 + v] = (bf16)f2bf(hv[tt] * rs * hnorm[h * 256 + v] / (1.0f + __expf(-o))); } }
    }
}

template <class Epi>
__device__ __forceinline__ void run_gemm(LAS unsigned char* lds, const bf16* A, const bf16* Bt, int M, int N, int K, const Epi& E, int tid, int bid, int nb) {
    pg8::Gemm g{A, Bt, M, N, K, K / 64}; pg8::StaticOrder S; S.init(M, N, nb, bid);
    pg8::gemm_phase<Epi, pg8::StaticOrder, false, true>(lds, g, S, E, tid);
}
template <int NS>
__device__ __forceinline__ void run_gemm_sample_split(LAS unsigned char* lds, const bf16* A, const bf16* Bt, int K, float* PART, const float* bias, float scale, int tid, int bid, int nb) {
    const int item = bid; const bool has = item < 16 * NS; const int tile = item / NS, ks = item % NS; const int klen = K / NS;
    pg8::Gemm g{A + (size_t)ks * klen, Bt + (size_t)ks * klen, MT, D, K, klen / 64}; pg8::OneUnit S{MP / 256 + (tile >> 2), tile & 3, has};
    pg8::EpiPartial E{PART + (size_t)ks * 1048576, bias, scale, ks == 0};
    pg8::gemm_phase<pg8::EpiPartial, pg8::OneUnit, false, true>(lds, g, S, E, tid);
}

#define XB_TMO      128
#define XB_XCNT(j)  (256  + 64 * (j))
#define XB_XSUB(j)  (1280 + 64 * (j))
#define XB_XGEN(j)  (2304 + 64 * (j))
#define XB_TOP      3328
#define XB_TOPGEN   3392
#define XCD_BAR_WORDS 3456
#define XB_SPIN_CAP (1u << 18)

__device__ __forceinline__ unsigned xb_ld(unsigned* p)              { return __hip_atomic_load(p, __ATOMIC_RELAXED, __HIP_MEMORY_SCOPE_AGENT); }
__device__ __forceinline__ unsigned xb_add(unsigned* p, unsigned v) { return __hip_atomic_fetch_add(p, v, __ATOMIC_RELAXED, __HIP_MEMORY_SCOPE_AGENT); }
__device__ __forceinline__ unsigned xb_xcc_id() { return (unsigned)__builtin_amdgcn_s_getreg((3 << 11) | 20) & 0xFu; }
#define XB_SPIN(cond, bar) do { unsigned _sp = 0; while (cond) { __builtin_amdgcn_s_sleep(1); \
    if ((++_sp & 255u) == 0u) { if (xb_ld(&(bar)[XB_TMO])) break; if (_sp > XB_SPIN_CAP) { atomicAdd(&(bar)[XB_TMO], 1u); break; } } } } while (0)

struct XcdBarrier {
    unsigned* bar; unsigned x;
    volatile LAS unsigned* st;
};

__device__ __forceinline__ XcdBarrier xcd_barrier_post(unsigned* bar, volatile LAS unsigned* st) {
    XcdBarrier b; b.bar = bar; b.x = xb_xcc_id(); b.st = st;
    if (threadIdx.x == 0) (void)xb_add(&bar[XB_XCNT(b.x)], 1u);
    return b;
}
__device__ __forceinline__ void xcd_barrier_complete(unsigned* bar, unsigned x, unsigned& nloc, unsigned& nx) {
    const unsigned G = gridDim.x * gridDim.y * gridDim.z;
    unsigned sum, cnt, mine, sp = 0u;
    for (;;) {
        sum = 0u; cnt = 0u; mine = 0u;
#pragma unroll
        for (unsigned j = 0; j < 16; ++j) { const unsigned c = xb_ld(&bar[XB_XCNT(j)]); sum += c; cnt += (c > 0u) ? 1u : 0u; mine = (j == x) ? c : mine; }
        if (sum == G) break;
        __builtin_amdgcn_s_sleep(1);
        if ((++sp & 255u) == 0u) { if (xb_ld(&bar[XB_TMO])) break; if (sp > XB_SPIN_CAP) { atomicAdd(&bar[XB_TMO], 1u); break; } }
    }
    nloc = mine > 0u ? mine : 1u; nx = cnt > 0u ? cnt : 1u;
}

__device__ __forceinline__ void xcd_barrier(const XcdBarrier& b) {
    asm volatile("s_waitcnt vmcnt(0)" ::: "memory");
    __syncthreads();
    if (threadIdx.x == 0) {
        unsigned* bar = b.bar;
        __builtin_amdgcn_s_waitcnt(0);
        unsigned nloc = b.st[0], nx = b.st[1];
        if (nloc == 0u) { xcd_barrier_complete(bar, b.x, nloc, nx); b.st[0] = nloc; b.st[1] = nx; }
        const unsigned old = xb_add(&bar[XB_XSUB(b.x)], 1u);
        const unsigned gen = old / nloc;
        if (old + 1u == (gen + 1u) * nloc) {
            __builtin_amdgcn_fence(__ATOMIC_RELEASE, "agent");
            asm volatile("s_waitcnt vmcnt(0)" ::: "memory");
            const unsigned og = xb_add(&bar[XB_TOP], 1u);
            const unsigned tg = og / nx;
            if (og + 1u == (tg + 1u) * nx) xb_add(&bar[XB_TOPGEN], 1u);
            else XB_SPIN(xb_ld(&bar[XB_TOPGEN]) == tg, bar);
            __builtin_amdgcn_fence(__ATOMIC_ACQUIRE, "agent");
            xb_add(&bar[XB_XGEN(b.x)], 1u);
            asm volatile("s_waitcnt vmcnt(0)" ::: "memory");
        } else {
            XB_SPIN(xb_ld(&bar[XB_XGEN(b.x)]) == gen, bar);
            __builtin_amdgcn_fence(__ATOMIC_ACQUIRE, "agent");
            asm volatile("s_waitcnt vmcnt(0)" ::: "memory");
        }
    }
    __syncthreads();
}

#define PV int tid = threadIdx.x; int bid = blockIdx.x; asm volatile("" : "+v"(tid)); asm volatile("" : "+s"(bid)); const int nb = gridDim.x; \
    ArgsP ap = (ArgsP)__builtin_amdgcn_kernarg_segment_ptr(); asm volatile("" : "+s"(ap)); unsigned char* ws = ap->ws; float* XRES = ap->out; (void)ws; (void)XRES; \
    const int lane = tid & 63, wave = __builtin_amdgcn_readfirstlane(tid >> 6); const int gw = bid * 8 + wave, ngw = nb * 8, gtid = bid * NTHR + tid, ngt = nb * NTHR; \
    (void)lane; (void)wave; (void)gw; (void)ngw; (void)gtid; (void)ngt;
#define XBAR() do { XcdBarrier b_; b_.bar = (unsigned*)(((ArgsP)__builtin_amdgcn_kernarg_segment_ptr())->ws); b_.x = xb_xcc_id(); b_.st = (volatile LAS unsigned*)(lds + LDS_BYTES - 64); xcd_barrier(b_); } while (0)
#ifdef PROBE_SYNC
#define GSYNC() do { XBAR(); XBAR(); } while (0)
#else
#define GSYNC() XBAR()
#endif
#define REPX for (int rep_ = 0; rep_ < 2; ++rep_)
#ifdef PROBE_MA
#define DUP_MA(...) __VA_ARGS__ __VA_ARGS__
#else
#define DUP_MA(...) __VA_ARGS__
#endif
#ifdef PROBE_MB
#define DUP_MB(...) __VA_ARGS__ __VA_ARGS__
#else
#define DUP_MB(...) __VA_ARGS__
#endif
#ifdef PROBE_MC
#define DUP_MC(...) __VA_ARGS__ __VA_ARGS__
#else
#define DUP_MC(...) __VA_ARGS__
#endif
#ifdef PROBE_P0
#define REP_P0 REPX
#else
#define REP_P0
#endif
#ifdef PROBE_MLSTM
#define REP_ML REPX
#else
#define REP_ML
#endif
#ifdef PROBE_ATTN
#define REP_AT REPX
#else
#define REP_AT
#endif
#ifdef PROBE_GEMM
#define REP_GE REPX
#else
#define REP_GE
#endif
#define XN_ ((bf16*)(ws + WS_XN))
#define XN2_ ((bf16*)(ws + WS_XN2))
#define ACT_ ((bf16*)(ws + WS_ACT))
#define PROJ_ ((bf16*)(ws + WS_ACT))
#define GATES_ ((float*)(ws + WS_GATES))
#define AB_ ((float*)(ws + WS_AB))
#define MSb_ ((float*)(ws + WS_MS))
#define NS_ ((float*)(ws + WS_NS))
#define DN_ ((float*)(ws + WS_DN))
#define DCT_ ((float*)(ws + WS_DCT))
#define CTS_ ((bf16*)(ws + WS_CTS))
#define QB_ ((bf16*)(ws + WS_QB))
#define KVRAW_ ((float*)(ws + WS_KVRAW))
#define PART_ ((float*)(ws + WS_PART))

template <int l>
__device__ __forceinline__ void layer_body(LAS unsigned char* lds) {
        if (l == 2) REP_GE { PV pg8::EpiF32 E{KVRAW_, 512, ap->in[18]}; run_gemm(lds, XN2_, (const bf16*)(ws + WS_WKV), MT, 512, D, E, tid, bid, nb); }
        REP_GE { PV pg8::EpiSwiGLU E{ACT_, DFF}; run_gemm(lds, XN_, (const bf16*)(ws + WS_WGU + (size_t)(2 * l) * SZ_WGU), MT, NGU, D, E, tid, bid, nb); }
        GSYNC();
        { PV pg8::EpiResid E{XRES, D, nullptr, 0.5f}; run_gemm(lds, ACT_, (const bf16*)(ws + WS_WD + (size_t)(2 * l) * SZ_WD), MP, D, DFF, E, tid, bid, nb); }
        { PV run_gemm_sample_split<11>(lds, ACT_, (const bf16*)(ws + WS_WD + (size_t)(2 * l) * SZ_WD), DFF, PART_, nullptr, 0.5f, tid, bid, nb); }
#ifdef PROBE_DOWN
        { PV pg8::EpiResid E{XRES, D, nullptr, 0.0f}; run_gemm(lds, ACT_, (const bf16*)(ws + WS_WD + (size_t)(2 * l) * SZ_WD), MP, D, DFF, E, tid, bid, nb); }
        { PV run_gemm_sample_split<11>(lds, ACT_, (const bf16*)(ws + WS_WD + (size_t)(2 * l) * SZ_WD), DFF, PART_, nullptr, 0.5f, tid, bid, nb); }
#endif
        GSYNC();
        if (l < 2) { PV
            LAS float* wg = (LAS float*)(lds + 128);
            for (int i = tid; i < 8192; i += NTHR) wg[i] = ap->in[12][(size_t)l * D * APROJ + (size_t)(i >> 3) * APROJ + 3072 + (i & 7)];
            __syncthreads();
            norm_phase(XRES, XRES + (size_t)MP * D, nullptr, ap->in[11] + l * D, XN_, nullptr, nullptr, nullptr, wg, ap->in[13] + l * 8, GATES_, PART_, 11, XRES, gw, ngw, lane);
        } else {
            { PV norm_phase(XRES, XRES + (size_t)MP * D, nullptr, ap->in[11] + l * D, XN_, nullptr, nullptr, nullptr, nullptr, nullptr, nullptr, PART_, 11, XRES, gw, ngw, lane); }
#ifdef PROBE_NORM
        { PV norm_phase(XRES, XRES + (size_t)MP * D, nullptr, ap->in[11] + l * D, XN_, nullptr, nullptr, nullptr, nullptr, nullptr, nullptr, nullptr, 0, nullptr, gw, ngw, lane); }
#endif
            if (l == 2) { PV kv_finalize(ap, gtid, ngt); }
        }
        GSYNC();
        if (l < 2) {
            REP_GE { PV pg8::EpiBf16B E{PROJ_, NPROJ, nullptr}; run_gemm(lds, XN_, (const bf16*)(ws + WS_WIN + (size_t)l * SZ_WIN), MT, NPROJ, D, E, tid, bid, nb); }
            GSYNC();
            DUP_MA({ PV mlstm_a_units(PROJ_, GATES_, DCT_, DN_, AB_, lds, tid, wave, lane, bid, nb); })
            DUP_MA({ PV mlstm_sample_units(PROJ_, GATES_, ap->in[2] + (size_t)l * 128 * 4 * 128 * 256, ap->in[3] + (size_t)l * 128 * 4 * 128, ap->in[4] + (size_t)l * 512, ap->in[14] + l * D, XN_,
                               ap->out + OFF_SC + (size_t)l * 128 * 4 * 128 * 256, ap->out + OFF_SN + (size_t)l * 128 * 4 * 128, ap->out + OFF_SM + (size_t)l * 512, lds, tid, wave, lane, bid, nb); })
            GSYNC();
            DUP_MB({ PV mlstm_b(DCT_, DN_, AB_, CTS_, NS_, MSb_, ap->out + OFF_PC + (size_t)l * 262144, ap->out + OFF_PN + (size_t)l * 1024, ap->out + OFF_PM + (size_t)l * 8, gtid, ngt); })
            GSYNC();
            DUP_MC({ PV mlstm_c_units(PROJ_, GATES_, CTS_, NS_, MSb_, ap->in[14] + l * D, XN_, lds, tid, wave, lane, bid, nb); })
            GSYNC();
            { PV pg8::EpiResid E{XRES, D, nullptr, 1.0f}; run_gemm(lds, XN_, (const bf16*)(ws + WS_WOUT + (size_t)l * SZ_SQ), MP, D, D, E, tid, bid, nb); }
            { PV run_gemm_sample_split<4>(lds, XN_, (const bf16*)(ws + WS_WOUT + (size_t)l * SZ_SQ), D, PART_, nullptr, 1.0f, tid, bid, nb); }
        } else {
            const int j = l - 2;
            REP_GE { PV pg8::EpiBf16B E{QB_, D, ap->in[20] + j * D}; run_gemm(lds, XN_, (const bf16*)(ws + WS_WQ + (size_t)j * SZ_SQ), MP, D, D, E, tid, bid, nb); }
            { PV run_gemm_sample_split<4>(lds, XN_, (const bf16*)(ws + WS_WQ + (size_t)j * SZ_SQ), D, PART_, ap->in[20] + j * D, 1.0f, tid, bid, nb); }
            GSYNC();
            REP_AT { PV attn_units<16, false>(QB_, (const bf16*)(ws + WS_KB), (const bf16*)(ws + WS_VB), XN_, ap->in[21] + j * 16, (const float*)(ws + WS_ROPE), PART_, lds, tid, wave, lane, bid, nb); }
            REP_AT { PV attn_units<10, true>(QB_, (const bf16*)(ws + WS_SKB), (const bf16*)(ws + WS_SVB), XN_, ap->in[21] + j * 16, (const float*)(ws + WS_ROPE), PART_, lds, tid, wave, lane, bid, nb); }
            GSYNC();
            { PV pg8::EpiResid E{XRES, D, ap->in[23] + j * D, 1.0f}; run_gemm(lds, XN_, (const bf16*)(ws + WS_WO + (size_t)j * SZ_SQ), MP, D, D, E, tid, bid, nb); }
            { PV run_gemm_sample_split<4>(lds, XN_, (const bf16*)(ws + WS_WO + (size_t)j * SZ_SQ), D, PART_, ap->in[23] + j * D, 1.0f, tid, bid, nb); }
        }
        GSYNC();
        { PV norm_phase(XRES, XRES + (size_t)MP * D, nullptr, ap->in[7] + (2 * l + 1) * D, XN_, nullptr, nullptr, nullptr, nullptr, nullptr, nullptr, PART_, 4, XRES, gw, ngw, lane); }
#ifdef PROBE_NORM
        { PV norm_phase(XRES, XRES + (size_t)MP * D, nullptr, ap->in[7] + (2 * l + 1) * D, XN_, nullptr, nullptr, nullptr, nullptr, nullptr, nullptr, nullptr, 0, nullptr, gw, ngw, lane); }
#endif
        GSYNC();
        REP_GE { PV pg8::EpiSwiGLU E{ACT_, DFF}; run_gemm(lds, XN_, (const bf16*)(ws + WS_WGU + (size_t)(2 * l + 1) * SZ_WGU), MT, NGU, D, E, tid, bid, nb); }
        GSYNC();
        { PV pg8::EpiResid E{XRES, D, nullptr, 0.5f}; run_gemm(lds, ACT_, (const bf16*)(ws + WS_WD + (size_t)(2 * l + 1) * SZ_WD), MP, D, DFF, E, tid, bid, nb); }
        { PV run_gemm_sample_split<11>(lds, ACT_, (const bf16*)(ws + WS_WD + (size_t)(2 * l + 1) * SZ_WD), DFF, PART_, nullptr, 0.5f, tid, bid, nb); }
#ifdef PROBE_DOWN
        { PV pg8::EpiResid E{XRES, D, nullptr, 0.0f}; run_gemm(lds, ACT_, (const bf16*)(ws + WS_WD + (size_t)(2 * l + 1) * SZ_WD), MP, D, DFF, E, tid, bid, nb); }
        { PV run_gemm_sample_split<11>(lds, ACT_, (const bf16*)(ws + WS_WD + (size_t)(2 * l + 1) * SZ_WD), DFF, PART_, nullptr, 0.5f, tid, bid, nb); }
#endif
        GSYNC();
        if (l < 3) { PV norm_phase(XRES, XRES + (size_t)MP * D, nullptr, ap->in[7] + (2 * l + 2) * D, XN_, ap->in[16], (l == 1) ? XN2_ : nullptr, nullptr, nullptr, nullptr, nullptr, PART_, 11, XRES, gw, ngw, lane); }
#ifdef PROBE_NORM
        if (l < 3) { PV norm_phase(XRES, XRES + (size_t)MP * D, nullptr, ap->in[7] + (2 * l + 2) * D, XN_, ap->in[16], (l == 1) ? XN2_ : nullptr, nullptr, nullptr, nullptr, nullptr, nullptr, 0, nullptr, gw, ngw, lane); }
#endif
        else { PV norm_phase(XRES, XRES + (size_t)MP * D, nullptr, ap->in[24], nullptr, nullptr, nullptr, XRES, nullptr, nullptr, nullptr, PART_, 11, nullptr, gw, ngw, lane); }
        if (l < 3) GSYNC();
}

__global__ void __launch_bounds__(NTHR, 2) mk_fwd(Args a) {
    extern __shared__ __attribute__((aligned(16))) unsigned char lds_raw[];
    LAS unsigned char* lds = (LAS unsigned char*)lds_raw;
    cg::grid_group grid = cg::this_grid();
    if (a.ws == nullptr) grid.sync();
    volatile LAS unsigned* bst = (volatile LAS unsigned*)(lds + LDS_BYTES - 64);
    if (threadIdx.x < 16) bst[threadIdx.x] = 0u;
    __syncthreads();
    (void)xcd_barrier_post((unsigned*)a.ws, bst);


    REP_P0 { PV rope_table(ap, gw, ngw, lane); convert_group<0>(ap, lds, wave, lane, gw, ngw); convert_group<1>(ap, lds, wave, lane, gw, ngw); convert_group<2>(ap, lds, wave, lane, gw, ngw); convert_group<3>(ap, lds, wave, lane, gw, ngw); }
    { PV norm_phase(ap->in[0], ap->in[1], XRES, ap->in[7], XN_, nullptr, nullptr, nullptr, nullptr, nullptr, nullptr, nullptr, 0, nullptr, gw, ngw, lane); }
    GSYNC();

    layer_body<0>(lds); layer_body<1>(lds); layer_body<2>(lds); layer_body<3>(lds);
}

extern "C" void kernel_launch(void* const* d_in, const int* in_sizes, int n_in, void* d_out, int out_size, void* d_ws, size_t ws_size, hipStream_t stream) {
    static int grid = 0;
    if (grid == 0) {
        if (n_in != 25 || (size_t)out_size != OUT_TOTAL || ws_size < WS_TOTAL) {
            fprintf(stderr, "kernel_launch: unexpected shapes: n_in %d out %d ws %zu (need %zu)\n", n_in, out_size, ws_size, (size_t)WS_TOTAL); grid = -1; return; }
        int dev = 0, cus = 0, per_cu = 0;
        (void)hipGetDevice(&dev); (void)hipDeviceGetAttribute(&cus, hipDeviceAttributeMultiprocessorCount, dev);
        (void)hipFuncSetAttribute((const void*)mk_fwd, hipFuncAttributeMaxDynamicSharedMemorySize, LDS_BYTES);
        if (hipOccupancyMaxActiveBlocksPerMultiprocessor(&per_cu, (const void*)mk_fwd, NTHR, LDS_BYTES) != hipSuccess || per_cu < 1) per_cu = 1;
        (void)hipGetLastError();
        if (cus <= 0) cus = 256;
        grid = cus;
    }
    if (grid < 0) return;
    (void)hipMemsetAsync(d_ws, 0, 16384, stream);
    Args a{};
    for (int i = 0; i < 25; ++i) a.in[i] = (const float*)d_in[i];
    a.out = (float*)d_out; a.ws = (unsigned char*)d_ws;
    void* args[] = {&a};
    hipError_t e = hipLaunchCooperativeKernel((const void*)mk_fwd, dim3(grid), dim3(NTHR), args, LDS_BYTES, stream);
    if (e != hipSuccess) fprintf(stderr, "cooperative launch failed: %s (grid %d)\n", hipGetErrorString(e), grid);
}
```

```cpp
#include <hip/hip_runtime.h>
#include <hip/hip_cooperative_groups.h>
#include <cstdio>
#include <cstdint>
namespace cg = cooperative_groups;
namespace pg8 {
#define PG8_LAS __attribute__((address_space(3)))
typedef unsigned short bf16_t;
typedef short bf16x8 __attribute__((ext_vector_type(8)));
typedef float f32x4 __attribute__((ext_vector_type(4)));
typedef unsigned u32x4 __attribute__((ext_vector_type(4)));
constexpr int BM = 256, BK = 64, HALF = 128, HTB = HALF * BK * 2  , STAGE_BYTES = 8 * HTB, NXCD = 8, WGM = 8;

__host__ __device__ __forceinline__ int lds_byte(int r, int c) { const int st = (r >> 4) * 2 + (c >> 5), rr = r & 15, cc = c & 31, ob = rr * 64 + cc * 2; return st * 1024 + (ob ^ (((ob >> 9) & 1) << 5)); }
__host__ __device__ __forceinline__ void stage_rc(int b, int& R, int& C) { const int st = b / 1024, sb = b % 1024, swz = sb ^ (((sb >> 9) & 1) << 5); R = (st >> 1) * 16 + swz / 64; C = (st & 1) * 32 + (swz % 64) / 2; }
__host__ __device__ __forceinline__ int perm32(int rho) { const int n = rho >> 4, i = rho & 15; return 8 * (i >> 2) + 4 * n + (i & 3); }

struct Unit { int pm, pn; };
struct Gemm { const bf16_t* A; const bf16_t* Bt; int M, N, K, nt; };

struct StaticOrder {
    int nM, nN, nwg, G, c;
    __host__ __device__ void init(int M, int N, int G_, int c_) { nM = M / BM; nN = N / BM; nwg = nM * nN; G = G_; c = c_; }
    __host__ __device__ bool next(int i, Unit& u) const {
        const long L = (long)i * G + c; if (L >= nwg) return false;
        int wgid = (int)L; { const int q = nwg / NXCD, r = nwg % NXCD, xcd = wgid % NXCD, off = wgid / NXCD; wgid = (xcd < r ? xcd * (q + 1) : r * (q + 1) + (xcd - r) * q) + off; }
        const int nig = WGM * nN, gid = wgid / nig, fm = gid * WGM, gsz = (nM - fm) < WGM ? (nM - fm) : WGM;
        u.pm = fm + ((wgid % nig) % gsz); u.pn = (wgid % nig) / gsz; return true;
    }
    __device__ __forceinline__ void a_ready(const Unit&) const {}
    __device__ __forceinline__ void done(const Unit&) const {}
};

__device__ __forceinline__ unsigned cvt_pk_bf16(float lo, float hi) { unsigned r; asm volatile("v_cvt_pk_bf16_f32 %0, %1, %2" : "=v"(r) : "v"(lo), "v"(hi)); return r; }
typedef float f32x2 __attribute__((ext_vector_type(2)));
struct EpiBf16B {
    static constexpr bool PERM = true, AFTER_DRAIN = false;
    bf16_t* O; int ldc; const float* bias;
    __device__ __forceinline__ void operator()(const f32x4 (&acc)[2][2][4][2], const Unit& u, int wr, int wc, int fr, int fq) const {
        const int row0 = u.pm * BM + wr * 64 + fr; const int col0 = u.pn * BM + wc * 32 + 8 * fq;
        f32x4 bv[2][2];
#pragma unroll
        for (int bj = 0; bj < 2; ++bj)
#pragma unroll
            for (int n = 0; n < 2; ++n) bv[bj][n] = bias ? *(const f32x4*)(bias + col0 + bj * HALF + 4 * n) : (f32x4){0.f, 0.f, 0.f, 0.f};
#pragma unroll
        for (int ai = 0; ai < 2; ++ai)
#pragma unroll
            for (int m = 0; m < 4; ++m) { bf16_t* rowp = O + (size_t)(row0 + ai * HALF + m * 16) * ldc + col0;
#pragma unroll
                for (int bj = 0; bj < 2; ++bj) { const f32x4 v0 = acc[ai][bj][m][0] + bv[bj][0], v1 = acc[ai][bj][m][1] + bv[bj][1];
                    u32x4 w; w.x = cvt_pk_bf16(v0[0], v0[1]); w.y = cvt_pk_bf16(v0[2], v0[3]); w.z = cvt_pk_bf16(v1[0], v1[1]); w.w = cvt_pk_bf16(v1[2], v1[3]);
                    *(u32x4*)(rowp + bj * HALF) = w; } }
    }
};
__device__ __forceinline__ float silu_mul(float g, float u) { return g * u * __builtin_amdgcn_rcpf(1.0f + __builtin_amdgcn_exp2f(g * -1.4426950408889634f)); }
struct EpiSwiGLU {
    static constexpr bool PERM = true, AFTER_DRAIN = false;
    bf16_t* O; int ldc;
    __device__ __forceinline__ void operator()(const f32x4 (&acc)[2][2][4][2], const Unit& u, int wr, int wc, int fr, int fq) const {
        const int row0 = u.pm * BM + wr * 64 + fr; const int col0 = u.pn * HALF + wc * 32 + 8 * fq;
#pragma unroll
        for (int ai = 0; ai < 2; ++ai)
#pragma unroll
            for (int m = 0; m < 4; ++m) { bf16_t* rowp = O + (size_t)(row0 + ai * HALF + m * 16) * ldc + col0;
                const f32x4 g0 = acc[ai][0][m][0], g1 = acc[ai][0][m][1], u0 = acc[ai][1][m][0], u1 = acc[ai][1][m][1];
                u32x4 w; w.x = cvt_pk_bf16(silu_mul(g0[0], u0[0]), silu_mul(g0[1], u0[1])); w.y = cvt_pk_bf16(silu_mul(g0[2], u0[2]), silu_mul(g0[3], u0[3]));
                w.z = cvt_pk_bf16(silu_mul(g1[0], u1[0]), silu_mul(g1[1], u1[1])); w.w = cvt_pk_bf16(silu_mul(g1[2], u1[2]), silu_mul(g1[3], u1[3]));
                *(u32x4*)rowp = w; }
    }
};
struct EpiResid {
    static constexpr bool PERM = false, AFTER_DRAIN = false;
    float* X; int ldc; const float* bias; float scale;
    __device__ __forceinline__ void operator()(const f32x4 (&acc)[2][2][4][2], const Unit& u, int wr, int wc, int fr, int fq) const {
        const int col0 = u.pn * BM + wc * 32 + 4 * fq;
        f32x4 bv[2][2];
#pragma unroll
        for (int bj = 0; bj < 2; ++bj)
#pragma unroll
            for (int n = 0; n < 2; ++n) bv[bj][n] = bias ? *(const f32x4*)(bias + col0 + bj * HALF + n * 16) : (f32x4){0.f, 0.f, 0.f, 0.f};
#pragma unroll
        for (int ai = 0; ai < 2; ++ai) {
            float* base = X + (size_t)(u.pm * BM + ai * HALF + wr * 64 + fr) * ldc + col0;
            f32x4 old[4][2][2];
#pragma unroll
            for (int m = 0; m < 4; ++m)
#pragma unroll
                for (int bj = 0; bj < 2; ++bj)
#pragma unroll
                    for (int n = 0; n < 2; ++n) old[m][bj][n] = *(const f32x4*)(base + (size_t)(m * 16) * ldc + bj * HALF + n * 16);
#pragma unroll
            for (int m = 0; m < 4; ++m)
#pragma unroll
                for (int bj = 0; bj < 2; ++bj)
#pragma unroll
                    for (int n = 0; n < 2; ++n) *(f32x4*)(base + (size_t)(m * 16) * ldc + bj * HALF + n * 16) = old[m][bj][n] + (acc[ai][bj][m][n] + bv[bj][n]) * scale;
            asm volatile("" ::: "memory"); }
    }
};
struct EpiF32 {
    static constexpr bool PERM = false, AFTER_DRAIN = false;
    float* O; int ldc; const float* bias;
    __device__ __forceinline__ void operator()(const f32x4 (&acc)[2][2][4][2], const Unit& u, int wr, int wc, int fr, int fq) const {
        const int col0 = u.pn * BM + wc * 32 + 4 * fq;
#pragma unroll
        for (int ai = 0; ai < 2; ++ai)
#pragma unroll
            for (int m = 0; m < 4; ++m) { float* rowp = O + (size_t)(u.pm * BM + ai * HALF + wr * 64 + m * 16 + fr) * ldc + col0;
#pragma unroll
                for (int bj = 0; bj < 2; ++bj)
#pragma unroll
                    for (int n = 0; n < 2; ++n) { const f32x4 bvv = *(const f32x4*)(bias + col0 + bj * HALF + n * 16); *(f32x4*)(rowp + bj * HALF + n * 16) = acc[ai][bj][m][n] + bvv; } }
    }
};
struct OneUnit {
    int pm, pn; bool has;
    __device__ __forceinline__ bool next(int i, Unit& u) const { if (i == 0 && has) { u.pm = pm; u.pn = pn; return true; } return false; }
    __device__ __forceinline__ void a_ready(const Unit&) const {}
    __device__ __forceinline__ void done(const Unit&) const {}
};
struct EpiPartial {
    static constexpr bool PERM = false, AFTER_DRAIN = false;
    float* P; const float* bias; float scale; bool addbias;
    __device__ __forceinline__ void operator()(const f32x4 (&acc)[2][2][4][2], const Unit& u, int wr, int wc, int fr, int fq) const {
        const int col0 = u.pn * BM + wc * 32 + 4 * fq;
        f32x4 bv[2][2];
#pragma unroll
        for (int bj = 0; bj < 2; ++bj)
#pragma unroll
            for (int n = 0; n < 2; ++n) bv[bj][n] = (bias && addbias) ? *(const f32x4*)(bias + col0 + bj * HALF + n * 16) : (f32x4){0.f, 0.f, 0.f, 0.f};
#pragma unroll
        for (int ai = 0; ai < 2; ++ai)
#pragma unroll
            for (int m = 0; m < 4; ++m) { float* rowp = P + (size_t)((u.pm - 64) * BM + ai * HALF + wr * 64 + m * 16 + fr) * 1024 + col0;
#pragma unroll
                for (int bj = 0; bj < 2; ++bj)
#pragma unroll
                    for (int n = 0; n < 2; ++n) *(f32x4*)(rowp + bj * HALF + n * 16) = (acc[ai][bj][m][n] + bv[bj][n]) * scale; }
    }
};
template <class Epi, class Sched, bool ALIGN_EPI = false, bool SP2 = false>
__device__ __forceinline__ void gemm_phase(PG8_LAS unsigned char* lds, const Gemm g, const Sched& S, const Epi& E, const int tid_in) {
    const int tid = tid_in, wid = __builtin_amdgcn_readfirstlane(tid >> 6), lane = tid & 63, wr = wid >> 2, wc = wid & 3, fr = lane & 15, fq = lane >> 4;
    const int K = g.K, nt = g.nt;
    unsigned voffA[2], voffB[2];
#pragma unroll
    for (int i = 0; i < 2; ++i) { int R, C; stage_rc(tid * 16 + i * 8192, R, C); const int Rb = Epi::PERM ? ((R & ~31) + perm32(R & 31)) : R;
        voffA[i] = (unsigned)(R * K + C) * 2u; voffB[i] = (unsigned)(Rb * K + C) * 2u; }
    const size_t kstep = (size_t)(BK * 2);
    const size_t hstep = (size_t)HALF * K * 2;
    const size_t tstep = 2 * hstep;
    const unsigned ldsw = (unsigned)wid * 1024u;
    const int aoff = lds_byte(wr * 64 + fr, fq * 8), boff = lds_byte(wc * 32 + fr, fq * 8);
#define PG8_SA(b, h) (((b) * 2 + (h)) * HTB)
#define PG8_SB(b, h) ((4 + (b) * 2 + (h)) * HTB)
#define PG8_STAGE(bufoff, gbase, voff) do { _Pragma("unroll") for (int _i = 0; _i < 2; ++_i) \
        __builtin_amdgcn_global_load_lds((const unsigned*)((const char*)(gbase) + (voff)[_i]), (PG8_LAS unsigned*)(lds + (bufoff) + ldsw + _i * 8192), 16, 0, 0); } while (0)
#define PG8_LDA(dst, b, h) do { _Pragma("unroll") for (int m = 0; m < 4; ++m) _Pragma("unroll") for (int k = 0; k < 2; ++k) dst[m][k] = *(const PG8_LAS bf16x8*)(lds + PG8_SA(b, h) + aoff + m * 2048 + k * 1024); } while (0)
#define PG8_LDB(dst, b, h) do { _Pragma("unroll") for (int n = 0; n < 2; ++n) _Pragma("unroll") for (int k = 0; k < 2; ++k) dst[n][k] = *(const PG8_LAS bf16x8*)(lds + PG8_SB(b, h) + boff + n * 2048 + k * 1024); } while (0)
#define PG8_MMA(ai, bj, At, Bt) do { __builtin_amdgcn_s_setprio(1); _Pragma("unroll") for (int m = 0; m < 4; ++m) _Pragma("unroll") for (int n = 0; n < 2; ++n) _Pragma("unroll") for (int k = 0; k < 2; ++k) \
        acc[ai][bj][m][n] = __builtin_amdgcn_mfma_f32_16x16x32_bf16(Bt[n][k], At[m][k], acc[ai][bj][m][n], 0, 0, 0); __builtin_amdgcn_s_setprio(0); } while (0)
#define PG8_WAIT_V(n) asm volatile("s_waitcnt vmcnt(" #n ")" ::: "memory")
#define PG8_WAIT_L(n) asm volatile("s_waitcnt lgkmcnt(" #n ")" ::: "memory")
#define PG8_BAR __builtin_amdgcn_s_barrier()
#define PG8_SCHED __builtin_amdgcn_sched_barrier(0)
    Unit cur, nxt; int ui = 0;
    if (!S.next(0, cur)) return;
    f32x4 acc[2][2][4][2];
#pragma unroll
    for (int a = 0; a < 2; ++a)
#pragma unroll
        for (int b = 0; b < 2; ++b)
#pragma unroll
            for (int m = 0; m < 4; ++m)
#pragma unroll
                for (int n = 0; n < 2; ++n) acc[a][b][m][n] = (f32x4){0.f, 0.f, 0.f, 0.f};
    bf16x8 At[4][2], B0[2][2], B1[2][2];
    const char* cA = (const char*)g.A + (size_t)cur.pm * tstep; const char* cB = (const char*)g.Bt + (size_t)cur.pn * tstep;
    S.a_ready(cur);
    if constexpr (SP2) {
        PG8_STAGE(PG8_SB(0, 0), cB, voffB); PG8_STAGE(PG8_SB(0, 1), cB + hstep, voffB); PG8_STAGE(PG8_SA(0, 0), cA, voffA); PG8_STAGE(PG8_SA(0, 1), cA + hstep, voffA);
        if (wr == 1) PG8_BAR;
        PG8_WAIT_V(2); PG8_BAR;
        PG8_STAGE(PG8_SB(1, 0), cB + kstep, voffB); PG8_STAGE(PG8_SA(1, 0), cA + kstep, voffA); PG8_STAGE(PG8_SB(1, 1), cB + hstep + kstep, voffB);
        PG8_WAIT_V(6); PG8_BAR;
    } else {
        PG8_STAGE(PG8_SB(0, 0), cB, voffB); PG8_STAGE(PG8_SA(0, 0), cA, voffA); PG8_STAGE(PG8_SB(0, 1), cB + hstep, voffB); PG8_STAGE(PG8_SA(0, 1), cA + hstep, voffA);
        if (wr == 1) PG8_BAR;
        PG8_WAIT_V(4); PG8_BAR;
        PG8_STAGE(PG8_SB(1, 0), cB + kstep, voffB); PG8_STAGE(PG8_SA(1, 0), cA + kstep, voffA); PG8_STAGE(PG8_SB(1, 1), cB + hstep + kstep, voffB);
        PG8_WAIT_V(6); PG8_BAR;
    }
    for (;;) {
        const bool has_next = S.next(ui + 1, nxt);
        const char* nA = has_next ? (const char*)g.A + (size_t)nxt.pm * tstep : cA; const char* nB = has_next ? (const char*)g.Bt + (size_t)nxt.pn * tstep : cB;
        for (int t = 0; t < nt; t += 2) {
            const bool last = (t == nt - 2);
            const char* a1 = cA + (size_t)(t + 1) * kstep;
            const char* a2 = last ? nA : cA + (size_t)(t + 2) * kstep; const char* b2 = last ? nB : cB + (size_t)(t + 2) * kstep;
            const char* a3 = a2 + kstep; const char* b3 = b2 + kstep;
            if (last && has_next) S.a_ready(nxt);
            if constexpr (SP2) {
            PG8_LDB(B0, 0, 0); PG8_LDB(B1, 0, 1); PG8_SCHED; PG8_LDA(At, 0, 0); PG8_STAGE(PG8_SA(1, 1), a1 + hstep, voffA);
            PG8_WAIT_V(8); PG8_WAIT_L(0); PG8_BAR; PG8_MMA(0, 0, At, B0); PG8_MMA(0, 1, At, B1); PG8_BAR; PG8_SCHED;
            PG8_LDA(At, 0, 1); PG8_STAGE(PG8_SB(0, 0), b2, voffB); PG8_STAGE(PG8_SB(0, 1), b2 + hstep, voffB); PG8_STAGE(PG8_SA(0, 0), a2, voffA);
            PG8_WAIT_V(8); PG8_WAIT_L(0); PG8_BAR; PG8_MMA(1, 0, At, B0); PG8_MMA(1, 1, At, B1); PG8_BAR; PG8_SCHED;
            PG8_LDB(B0, 1, 0); PG8_LDB(B1, 1, 1); PG8_SCHED; PG8_LDA(At, 1, 0); PG8_STAGE(PG8_SA(0, 1), a2 + hstep, voffA);
            PG8_WAIT_V(8); PG8_WAIT_L(0); PG8_BAR; PG8_MMA(0, 0, At, B0); PG8_MMA(0, 1, At, B1); PG8_BAR; PG8_SCHED;
            PG8_LDA(At, 1, 1); PG8_STAGE(PG8_SB(1, 0), b3, voffB); PG8_STAGE(PG8_SB(1, 1), b3 + hstep, voffB); PG8_STAGE(PG8_SA(1, 0), a3, voffA);
            PG8_WAIT_V(8); PG8_WAIT_L(0); PG8_BAR; PG8_MMA(1, 0, At, B0); PG8_MMA(1, 1, At, B1); PG8_BAR; PG8_SCHED;
            } else {
            PG8_LDB(B0, 0, 0); PG8_SCHED; PG8_LDA(At, 0, 0); PG8_STAGE(PG8_SA(1, 1), a1 + hstep, voffA);
            PG8_WAIT_L(8); PG8_BAR; PG8_WAIT_L(0); PG8_MMA(0, 0, At, B0); PG8_BAR; PG8_SCHED;
            PG8_LDB(B1, 0, 1); PG8_STAGE(PG8_SB(0, 0), b2, voffB);
            PG8_BAR; PG8_WAIT_L(0); PG8_MMA(0, 1, At, B1); PG8_BAR;
            PG8_LDA(At, 0, 1); PG8_STAGE(PG8_SA(0, 0), a2, voffA);
            PG8_BAR; PG8_WAIT_L(0); PG8_MMA(1, 0, At, B0); PG8_BAR; PG8_SCHED;
            PG8_STAGE(PG8_SB(0, 1), b2 + hstep, voffB);
            PG8_WAIT_V(6); PG8_BAR; PG8_MMA(1, 1, At, B1); PG8_BAR;
            PG8_LDB(B0, 1, 0); PG8_SCHED; PG8_LDA(At, 1, 0); PG8_STAGE(PG8_SA(0, 1), a2 + hstep, voffA);
            PG8_WAIT_L(8); PG8_BAR; PG8_WAIT_L(0); PG8_MMA(0, 0, At, B0); PG8_BAR; PG8_SCHED;
            PG8_LDB(B1, 1, 1); PG8_STAGE(PG8_SB(1, 0), b3, voffB);
            PG8_BAR; PG8_WAIT_L(0); PG8_MMA(0, 1, At, B1); PG8_BAR;
            PG8_LDA(At, 1, 1); PG8_STAGE(PG8_SA(1, 0), a3, voffA);
            PG8_BAR; PG8_WAIT_L(0); PG8_MMA(1, 0, At, B0); PG8_BAR; PG8_SCHED;
            PG8_STAGE(PG8_SB(1, 1), b3 + hstep, voffB);
            PG8_WAIT_V(6); PG8_BAR; PG8_MMA(1, 1, At, B1); PG8_BAR;
            }
        }
        if constexpr (ALIGN_EPI) { if (wr == 0) PG8_BAR; }
        if constexpr (!Epi::AFTER_DRAIN) { E(acc, cur, wr, wc, fr, fq); S.done(cur); }
        if (!has_next) break;
#pragma unroll
        for (int a = 0; a < 2; ++a)
#pragma unroll
            for (int b = 0; b < 2; ++b)
#pragma unroll
                for (int m = 0; m < 4; ++m)
#pragma unroll
                    for (int n = 0; n < 2; ++n) acc[a][b][m][n] = (f32x4){0.f, 0.f, 0.f, 0.f};
        cur = nxt; cA = nA; cB = nB; ++ui;
        if constexpr (ALIGN_EPI) { if (wr == 1) PG8_BAR; }
    }
    PG8_WAIT_V(0);
    if constexpr (!ALIGN_EPI) { if (wr == 0) PG8_BAR; }
    PG8_BAR;
    if constexpr (Epi::AFTER_DRAIN) { E.fused(acc, cur, wr, wc, fr, fq, lds, wid, lane); S.done(cur); }
#undef PG8_SA
#undef PG8_SB
#undef PG8_STAGE
#undef PG8_LDA
#undef PG8_LDB
#undef PG8_MMA
#undef PG8_WAIT_V
#undef PG8_WAIT_L
#undef PG8_BAR
#undef PG8_SCHED
}
}

#define LAS __attribute__((address_space(3)))
typedef unsigned short bf16;
typedef unsigned u32x4 __attribute__((ext_vector_type(4)));
typedef unsigned u32x2 __attribute__((ext_vector_type(2)));
typedef float f32x4 __attribute__((ext_vector_type(4)));
typedef float f32x2v __attribute__((ext_vector_type(2)));
typedef short bf16x8 __attribute__((ext_vector_type(8)));
#define LDS_WAIT() asm volatile("s_waitcnt lgkmcnt(0)" ::: "memory")

constexpr int D = 1024, MP = 16384, MSAMP = 1024, MT = 17408, DFF = 2816, NGU = 5632, NPROJ = 3072, APROJ = 3080;
constexpr int NTHR = 512;
constexpr float KSCALE = 0.08838834764831845f;
constexpr float EPS = 1e-6f;

constexpr size_t MiB = (size_t)1 << 20;
constexpr size_t SZ_WGU = (size_t)NGU * D * 2, SZ_WD = (size_t)D * DFF * 2, SZ_WIN = (size_t)NPROJ * D * 2, SZ_SQ = (size_t)D * D * 2;
constexpr size_t WS_ROPE = 65536;
constexpr size_t WS_WGU = 1 * MiB;
constexpr size_t WS_WD = WS_WGU + 8 * SZ_WGU;
constexpr size_t WS_WIN = WS_WD + 8 * SZ_WD;
constexpr size_t WS_WOUT = WS_WIN + 2 * SZ_WIN;
constexpr size_t WS_WKV = WS_WOUT + 2 * SZ_SQ;
constexpr size_t WS_WQ = WS_WKV + (size_t)512 * D * 2;
constexpr size_t WS_WO = WS_WQ + 2 * SZ_SQ;
constexpr size_t WS_XN = WS_WO + 2 * SZ_SQ;
constexpr size_t WS_ACT = WS_XN + (size_t)MT * D * 2;
constexpr size_t WS_GATES = WS_ACT + (size_t)MT * NPROJ * 2;
constexpr size_t WS_AB = WS_GATES + (size_t)MT * 8 * 4;
constexpr size_t WS_MS = WS_AB + 8192;
constexpr size_t WS_NS = WS_MS + 8192;
constexpr size_t WS_DN = WS_NS + (size_t)8 * 129 * 128 * 4;
constexpr size_t WS_R1 = ((WS_DN + (size_t)1024 * 128 * 4 + MiB - 1) / MiB) * MiB;
constexpr size_t WS_DCT = WS_R1;
constexpr size_t WS_CTS = WS_DCT + (size_t)1024 * 32768 * 4;
constexpr size_t WS_XN2 = WS_R1;
constexpr size_t WS_QB = WS_XN2 + (size_t)MT * D * 2;
constexpr size_t WS_KVRAW = WS_QB + (size_t)MT * D * 2;
constexpr size_t WS_KB = WS_KVRAW + (size_t)MT * 512 * 4;
constexpr size_t WS_VB = WS_KB + (size_t)MP * 256 * 2;
constexpr size_t WS_SKB = WS_VB + (size_t)MP * 256 * 2;
constexpr size_t WS_SVB = WS_SKB + (size_t)128 * 136 * 256 * 2;
constexpr size_t WS_END = WS_R1 + 192 * MiB;
constexpr size_t WS_PART = WS_END;
constexpr size_t WS_TOTAL = WS_PART + 44 * MiB;
static_assert(WS_SVB + (size_t)128 * 136 * 256 * 2 <= WS_END && WS_CTS + (size_t)1024 * 32768 * 2 <= WS_END, "ws map");

constexpr size_t OFF_Y = 0;
constexpr size_t OFF_PC = (size_t)MT * D;
constexpr size_t OFF_PN = OFF_PC + 524288;
constexpr size_t OFF_PM = OFF_PN + 2048;
constexpr size_t OFF_PK = OFF_PM + 16;
constexpr size_t OFF_PV = OFF_PK + 65536;
constexpr size_t OFF_SC = OFF_PV + 65536;
constexpr size_t OFF_SN = OFF_SC + 33554432;
constexpr size_t OFF_SM = OFF_SN + 131072;
constexpr size_t OFF_SK = OFF_SM + 1024;
constexpr size_t OFF_SV = OFF_SK + 4194304;
constexpr size_t OUT_TOTAL = OFF_SV + 4194304;

constexpr int LDS_BYTES = 147456;

struct Args { const float* in[25]; float* out; unsigned char* ws; };
typedef const __attribute__((address_space(4))) Args* ArgsP;

__device__ __forceinline__ unsigned f2bf(float f) { unsigned u = __builtin_bit_cast(unsigned, f); return (u + 0x7fffu + ((u >> 16) & 1u)) >> 16; }
__device__ __forceinline__ unsigned pk2(float lo, float hi) { return f2bf(lo) | (f2bf(hi) << 16); }
__device__ __forceinline__ float bf2f(unsigned h) { return __builtin_bit_cast(float, h << 16); }
__device__ __forceinline__ float bflo(unsigned w) { return __builtin_bit_cast(float, w << 16); }
__device__ __forceinline__ float bfhi(unsigned w) { return __builtin_bit_cast(float, w & 0xffff0000u); }
__device__ __forceinline__ float wave_sum(float v) {
#pragma unroll
    for (int o = 1; o < 64; o <<= 1) v += __shfl_xor(v, o);
    return v;
}
__device__ __forceinline__ float wave_max(float v) {
#pragma unroll
    for (int o = 1; o < 64; o <<= 1) v = fmaxf(v, __shfl_xor(v, o));
    return v;
}
__device__ __forceinline__ f32x4 mfma16(bf16x8 a, bf16x8 b, f32x4 c) { return __builtin_amdgcn_mfma_f32_16x16x32_bf16(a, b, c, 0, 0, 0); }
__device__ __forceinline__ void rope_cs(int pos, double invf, float& c, float& s) {
    const double ang = (double)pos * invf;
    const double r = ang - 6.283185307179586476925 * __builtin_rint(ang * 0.15915494309189533577);
    const float rf = (float)r; c = cosf(rf); s = sinf(rf);
}
#define ROPE_INVF { 1.0, 0.1939227447486858, 0.03760603093086394, 0.007292664737217109, 0.0014142135623730955, 0.00027424817567620724, 5.318295896944988e-05, 1.0313385377212461e-05 }

__device__ __forceinline__ void cvt_item(const float* W, int ldw, int k0, int n0, bf16* dst, int K, LAS float* scr, int lane) {
#pragma unroll 4
    for (int i = 0; i < 16; ++i) { const int kk = 4 * i + (lane >> 4); const f32x4 v = *(const f32x4*)(W + (size_t)(k0 + kk) * ldw + n0 + 4 * (lane & 15));
        LAS float* s = scr + kk * 65 + 4 * (lane & 15); s[0] = v.x; s[1] = v.y; s[2] = v.z; s[3] = v.w; }
    LDS_WAIT();
    const int c = lane & 7, nn = lane >> 3;
#pragma unroll
    for (int j = 0; j < 8; ++j) { const int n = nn + 8 * j; const LAS float* s = scr + (8 * c) * 65 + n;
        u32x4 o; o.x = pk2(s[0], s[65]); o.y = pk2(s[130], s[195]); o.z = pk2(s[260], s[325]); o.w = pk2(s[390], s[455]);
        *(u32x4*)(dst + (size_t)n * K + k0 + 8 * c) = o; }
    LDS_WAIT();
}
__device__ __forceinline__ void rope_table(ArgsP a, int gw, int ngw, int lane) {
    const double invf[8] = ROPE_INVF; float* rt = (float*)(a->ws + WS_ROPE);
    for (int it = gw * 64 + lane; it < 8200 * 8; it += ngw * 64) { const int pos = it >> 3, i = it & 7; double f = invf[0];
#pragma unroll
        for (int q = 1; q < 8; ++q) f = (i == q) ? invf[q] : f;
        float c, s; rope_cs(pos, f, c, s); rt[pos * 16 + i] = c; rt[pos * 16 + 8 + i] = s; }
}
template <int L>
__device__ __forceinline__ void convert_group(ArgsP a, LAS unsigned char* lds, int wave, int lane, int gw, int ngw) {
    LAS float* scr = (LAS float*)(lds + wave * 16640);
    unsigned char* ws = a->ws;
    constexpr int I_G = 16 * 44, I_D = 44 * 16, I_FF = 2 * I_G + I_D, I_IN = 16 * 48, I_SQ = 256, I_KV = 16 * 8;
    constexpr int NITEMS = 2 * I_FF + (L < 2 ? I_IN + I_SQ : (L == 2 ? I_KV + 2 * I_SQ : 2 * I_SQ));
    for (int it = gw; it < NITEMS; it += ngw) {
        int r = it;
        if (r < 2 * I_FF) { const int li = 2 * L + r / I_FF; r %= I_FF;
            if (r < 2 * I_G) { const int up = (r >= I_G) ? 1 : 0; r -= up * I_G; const int kb = r / 44, nb = r % 44; const int n0 = nb * 64;
                const float* W = (up ? a->in[9] : a->in[8]) + (size_t)li * D * DFF;
                bf16* dst = (bf16*)(ws + WS_WGU + (size_t)li * SZ_WGU) + (size_t)((n0 >> 7) * 256 + (n0 & 127) + up * 128) * D;
                cvt_item(W, DFF, kb * 64, n0, dst, D, scr, lane);
            } else { r -= 2 * I_G; const int kb = r / 16, nb = r % 16;
                cvt_item(a->in[10] + (size_t)li * DFF * D, D, kb * 64, nb * 64, (bf16*)(ws + WS_WD + (size_t)li * SZ_WD) + (size_t)nb * 64 * DFF, DFF, scr, lane); }
            continue; }
        r -= 2 * I_FF;
        if (L < 2) {
            if (r < I_IN) { const int kb = r / 48, nb = r % 48;
                cvt_item(a->in[12] + (size_t)L * D * APROJ, APROJ, kb * 64, nb * 64, (bf16*)(ws + WS_WIN + (size_t)L * SZ_WIN) + (size_t)nb * 64 * D, D, scr, lane); continue; }
            r -= I_IN; { const int kb = r / 16, nb = r % 16;
                cvt_item(a->in[15] + (size_t)L * D * D, D, kb * 64, nb * 64, (bf16*)(ws + WS_WOUT + (size_t)L * SZ_SQ) + (size_t)nb * 64 * D, D, scr, lane); }
        } else {
            if (L == 2) { if (r < I_KV) { const int kb = r / 8, nb = r % 8;
                    cvt_item(a->in[17], 512, kb * 64, nb * 64, (bf16*)(ws + WS_WKV) + (size_t)nb * 64 * D, D, scr, lane); continue; }
                r -= I_KV; }
            const int j = L - 2;
            if (r < I_SQ) { const int kb = r / 16, nb = r % 16;
                cvt_item(a->in[19] + (size_t)j * D * D, D, kb * 64, nb * 64, (bf16*)(ws + WS_WQ + (size_t)j * SZ_SQ) + (size_t)nb * 64 * D, D, scr, lane); continue; }
            r -= I_SQ; { const int kb = r / 16, nb = r % 16;
                cvt_item(a->in[22] + (size_t)j * D * D, D, kb * 64, nb * 64, (bf16*)(ws + WS_WO + (size_t)j * SZ_SQ) + (size_t)nb * 64 * D, D, scr, lane); }
        }
    }
}

__device__ __forceinline__ void norm_phase(const float* srcP, const float* srcS, float* xcopy, const float* g1, bf16* o1, const float* g2, bf16* o2, float* fout,
                                           const LAS float* wg, const float* bgate, float* gates, const float* part, int nparts, float* xwb, int gw, int ngw, int lane) {
    f32x4 gA[4], gB[4];
#pragma unroll
    for (int j = 0; j < 4; ++j) { gA[j] = ((const f32x4*)g1)[lane + 64 * j]; gB[j] = o2 ? ((const f32x4*)g2)[lane + 64 * j] : (f32x4){0.f, 0.f, 0.f, 0.f}; }
    const float bg = (wg && lane < 8) ? bgate[lane] : 0.f;
    f32x4 nv[4];
    if (gw < MT) { const float* xr = (gw < MP) ? srcP + (size_t)gw * D : srcS + (size_t)(gw - MP) * D;
#pragma unroll
        for (int j = 0; j < 4; ++j) nv[j] = ((const f32x4*)xr)[lane + 64 * j]; }
    for (int m = gw; m < MT; m += ngw) {
        f32x4 v[4]; float s = 0.f;
#pragma unroll
        for (int j = 0; j < 4; ++j) { v[j] = nv[j]; s += (v[j].x * v[j].x + v[j].y * v[j].y) + (v[j].z * v[j].z + v[j].w * v[j].w); }
        { const int mn = m + ngw;
            if (mn < MT) { const float* xn = (mn < MP) ? srcP + (size_t)mn * D : srcS + (size_t)(mn - MP) * D;
#pragma unroll
                for (int j = 0; j < 4; ++j) nv[j] = ((const f32x4*)xn)[lane + 64 * j]; } }
        if (part && m >= MP) {
#pragma unroll 4
            for (int p = 0; p < nparts; ++p) { const f32x4* pr = (const f32x4*)(part + (size_t)p * 1048576 + (size_t)(m - MP) * D);
#pragma unroll
                for (int j = 0; j < 4; ++j) v[j] += pr[lane + 64 * j]; }
            s = 0.f;
#pragma unroll
            for (int j = 0; j < 4; ++j) { s += (v[j].x * v[j].x + v[j].y * v[j].y) + (v[j].z * v[j].z + v[j].w * v[j].w); if (xwb) ((f32x4*)(xwb + (size_t)m * D))[lane + 64 * j] = v[j]; }
        }
        const float rstd = 1.0f / sqrtf(wave_sum(s) * (1.0f / D) + EPS);
        if (xcopy) {
#pragma unroll
            for (int j = 0; j < 4; ++j) ((f32x4*)(xcopy + (size_t)m * D))[lane + 64 * j] = v[j];
        }
        float ga[8];
#pragma unroll
        for (int q = 0; q < 8; ++q) ga[q] = 0.f;
#pragma unroll
        for (int j = 0; j < 4; ++j) { const f32x4 g = gA[j]; const f32x4 y = v[j] * rstd * g;
            if (fout) ((f32x4*)(fout + (size_t)m * D))[lane + 64 * j] = y;
            else { u32x2 w; w.x = pk2(y.x, y.y); w.y = pk2(y.z, y.w); ((u32x2*)(o1 + (size_t)m * D))[lane + 64 * j] = w; }
            if (wg) {
#pragma unroll
                for (int e = 0; e < 4; ++e) { const int k = 4 * (lane + 64 * j) + e; const f32x4 w0 = *(const LAS f32x4*)(wg + k * 8), w1 = *(const LAS f32x4*)(wg + k * 8 + 4); const float ye = y[e];
                    ga[0] += ye * w0.x; ga[1] += ye * w0.y; ga[2] += ye * w0.z; ga[3] += ye * w0.w; ga[4] += ye * w1.x; ga[5] += ye * w1.y; ga[6] += ye * w1.z; ga[7] += ye * w1.w; }
            }
        }
        if (o2) {
#pragma unroll
            for (int j = 0; j < 4; ++j) { const f32x4 g = gB[j]; const f32x4 y = v[j] * rstd * g;
                u32x2 w; w.x = pk2(y.x, y.y); w.y = pk2(y.z, y.w); ((u32x2*)(o2 + (size_t)m * D))[lane + 64 * j] = w; }
        }
        if (wg) {
#pragma unroll
            for (int q = 0; q < 8; ++q) ga[q] = wave_sum(ga[q]);
            float gv = ga[0];
#pragma unroll
            for (int q = 1; q < 8; ++q) gv = (lane == q) ? ga[q] : gv;
            if (lane < 8) { gv += bg; gv = 15.0f * tanhf(gv * (1.0f / 15.0f)); if (lane >= 4) gv = -log1pf(expf(-gv)); gates[(size_t)m * 8 + lane] = gv; }
        }
    }
}

__device__ __forceinline__ void store16(bf16* bdst, float* fdst, const float (&x)[16]) {
    u32x4 w0, w1; w0.x = pk2(x[0], x[1]); w0.y = pk2(x[2], x[3]); w0.z = pk2(x[4], x[5]); w0.w = pk2(x[6], x[7]);
    w1.x = pk2(x[8], x[9]); w1.y = pk2(x[10], x[11]); w1.z = pk2(x[12], x[13]); w1.w = pk2(x[14], x[15]);
    ((u32x4*)bdst)[0] = w0; ((u32x4*)bdst)[1] = w1;
    if (fdst) {
#pragma unroll
        for (int q = 0; q < 4; ++q) ((f32x4*)fdst)[q] = (f32x4){x[4 * q], x[4 * q + 1], x[4 * q + 2], x[4 * q + 3]};
    }
}
__device__ __forceinline__ void kv_finalize(ArgsP a, int gtid, int ngt) {
    unsigned char* ws = a->ws;
    const float* kvraw = (const float*)(ws + WS_KVRAW);
    bf16* KB = (bf16*)(ws + WS_KB); bf16* VB = (bf16*)(ws + WS_VB); bf16* SKB = (bf16*)(ws + WS_SKB); bf16* SVB = (bf16*)(ws + WS_SVB);
    float* out = a->out;
    for (int it = gtid; it < MT * 32; it += ngt) {
        const int part = it & 7, kvh = (it >> 3) & 3, m = it >> 5; const int isv = part >> 2, p = part & 3;
        const float* src = kvraw + (size_t)m * 512 + isv * 256 + kvh * 64 + p * 16;
        float x[16];
#pragma unroll
        for (int q = 0; q < 4; ++q) { const f32x4 t = ((const f32x4*)src)[q]; x[4 * q] = t.x; x[4 * q + 1] = t.y; x[4 * q + 2] = t.z; x[4 * q + 3] = t.w; }
        if (part == 0) {
            const int pos = (m < MP) ? (m & 8191) : 8192 + ((m - MP) & 7);
            const float* rt = (const float*)(ws + WS_ROPE) + (size_t)pos * 16;
            const f32x4 c0 = *(const f32x4*)rt, c1 = *(const f32x4*)(rt + 4), s0 = *(const f32x4*)(rt + 8), s1 = *(const f32x4*)(rt + 12);
            const float cs[8] = {c0.x, c0.y, c0.z, c0.w, c1.x, c1.y, c1.z, c1.w}, sn[8] = {s0.x, s0.y, s0.z, s0.w, s1.x, s1.y, s1.z, s1.w};
#pragma unroll
            for (int i = 0; i < 8; ++i) { const float c = cs[i], s = sn[i]; const float x1 = x[i], x2 = x[8 + i]; x[i] = x1 * c - x2 * s; x[8 + i] = x2 * c + x1 * s; }
        }
        bf16* bdst; float* fdst = nullptr;
        if (m < MP) { const int b = m >> 13, t = m & 8191; bdst = (isv ? VB : KB) + (size_t)m * 256 + kvh * 64 + p * 16;
            if (t >= 8192 - 128) fdst = out + (isv ? OFF_PV : OFF_PK) + ((size_t)(b * 128 + t - 8064) * 4 + kvh) * 64 + p * 16; }
        else { const int ms = m - MP, b = ms >> 3, t = ms & 7; bdst = (isv ? SVB : SKB) + (size_t)(b * 136 + 128 + t) * 256 + kvh * 64 + p * 16;
            fdst = out + (isv ? OFF_SV : OFF_SK) + ((size_t)(b * 128 + 120 + t) * 4 + kvh) * 64 + p * 16; }
        store16(bdst, fdst, x);
    }
    for (int it = gtid; it < 128 * 128 * 32; it += ngt) {
        const int part = it & 7, kvh = (it >> 3) & 3, i = (it >> 5) & 127, b = it >> 12; const int isv = part >> 2, p = part & 3;
        const float* src = (isv ? a->in[6] : a->in[5]) + ((size_t)(b * 128 + i) * 4 + kvh) * 64 + p * 16;
        float x[16];
#pragma unroll
        for (int q = 0; q < 4; ++q) { const f32x4 t = ((const f32x4*)src)[q]; x[4 * q] = t.x; x[4 * q + 1] = t.y; x[4 * q + 2] = t.z; x[4 * q + 3] = t.w; }
        bf16* bdst = (isv ? SVB : SKB) + (size_t)(b * 136 + i) * 256 + kvh * 64 + p * 16;
        float* fdst = (i >= 8) ? out + (isv ? OFF_SV : OFF_SK) + ((size_t)(b * 128 + i - 8) * 4 + kvh) * 64 + p * 16 : nullptr;
        store16(bdst, fdst, x);
    }
}

template <bool SAMPLE>
__device__ __forceinline__ void attn_rowmap(int wt, int q, int b, int kvh, int j, int& head, int& grow, int& qpos) {
    if (!SAMPLE) { head = kvh * 4 + (wt >> 3); const int rib = (wt & 7) * 16 + q; grow = b * 8192 + j * 128 + rib; qpos = j * 128 + rib; }
    else { head = kvh * 4 + 2 * wt + (q >> 3); const int t = q & 7; grow = MP + b * 8 + t; qpos = 8192 + t; }
}
template <int NKT, bool SAMPLE>
__device__ __forceinline__ void attn_units(const bf16* Q, const bf16* KBp, const bf16* VBp, bf16* O, const float* sinks, const float* rope, const float* qpart, LAS unsigned char* lds, int tid, int wave, int lane, int bid, int nb) {
    constexpr int NK = 16 * NKT, KSTR = 72, VSTR = NK + 8;
    LAS bf16* Ks = (LAS bf16*)lds; LAS bf16* VT = (LAS bf16*)(lds + 256 * KSTR * 2);
    const int l15 = lane & 15, g = lane >> 4;
    for (int u = bid; u < 512; u += nb) {
        int b, kvh, j = 0, nkeys, kbase; const bf16 *ksrc, *vsrc;
        if (!SAMPLE) { kvh = u & 3; j = (u >> 2) & 63; b = u >> 8; kbase = (j - 1) * 128; nkeys = 256;
            ksrc = KBp + ((ptrdiff_t)b * 8192 + kbase) * 256 + kvh * 64; vsrc = VBp + ((ptrdiff_t)b * 8192 + kbase) * 256 + kvh * 64; }
        else { kvh = u & 3; b = u >> 2; kbase = 8192 - 128; nkeys = 136; ksrc = KBp + (ptrdiff_t)b * 136 * 256 + kvh * 64; vsrc = VBp + (ptrdiff_t)b * 136 * 256 + kvh * 64; }
        __syncthreads();
        constexpr int NST = (NK * 8 + NTHR - 1) / NTHR; u32x4 kst[NST], vst[NST];
#pragma unroll
        for (int i = 0; i < NST; ++i) { const int c = tid + i * NTHR, key = c >> 3, cc = c & 7; const bool valid = (c < NK * 8) && (key < nkeys) && (kbase + key >= 0);
            kst[i] = (u32x4){0u, 0u, 0u, 0u}; vst[i] = (u32x4){0u, 0u, 0u, 0u};
            if (valid) { kst[i] = *(const u32x4*)(ksrc + (ptrdiff_t)key * 256 + cc * 8); vst[i] = *(const u32x4*)(vsrc + (ptrdiff_t)key * 256 + cc * 8); } }
#pragma unroll
        for (int i = 0; i < NST; ++i) { const int c = tid + i * NTHR, key = c >> 3, cc = c & 7;
            if (c < NK * 8) { *(LAS u32x4*)(Ks + key * KSTR + cc * 8) = kst[i]; const u32x4 vv = vst[i];
#pragma unroll
                for (int e = 0; e < 4; ++e) { VT[(cc * 8 + 2 * e) * VSTR + key] = (bf16)(vv[e] & 0xffffu); VT[(cc * 8 + 2 * e + 1) * VSTR + key] = (bf16)(vv[e] >> 16); } } }
        __syncthreads();
        const int ntile = SAMPLE ? 2 : 32;
        for (int wt = wave; wt < ntile; wt += 8) {
            int head, grow, qpos; attn_rowmap<SAMPLE>(wt, l15, b, kvh, j, head, grow, qpos);
            u32x4 q0, q1;
            if (!SAMPLE) { const bf16* qp = Q + (size_t)grow * D + head * 64 + 8 * g; q0 = *(const u32x4*)qp; q1 = *(const u32x4*)(qp + 32); }
            else {
                const float* pp = qpart + (size_t)(grow - MP) * D + head * 64 + 8 * g; f32x4 a0 = (f32x4){0.f, 0.f, 0.f, 0.f}, a1 = a0, b0 = a0, b1 = a0;
#pragma unroll
                for (int p = 0; p < 4; ++p) { const float* q4 = pp + (size_t)p * 1048576; a0 += *(const f32x4*)q4; a1 += *(const f32x4*)(q4 + 4); b0 += *(const f32x4*)(q4 + 32); b1 += *(const f32x4*)(q4 + 36); }
                q0.x = pk2(a0.x, a0.y); q0.y = pk2(a0.z, a0.w); q0.z = pk2(a1.x, a1.y); q0.w = pk2(a1.z, a1.w);
                q1.x = pk2(b0.x, b0.y); q1.y = pk2(b0.z, b0.w); q1.z = pk2(b1.x, b1.y); q1.w = pk2(b1.z, b1.w); }
            {
                u32x4 oth; oth.x = __shfl_xor(q0.x, 16); oth.y = __shfl_xor(q0.y, 16); oth.z = __shfl_xor(q0.z, 16); oth.w = __shfl_xor(q0.w, 16);
                if (g < 2) { const float sg = (g == 0) ? -1.0f : 1.0f; u32x4 r; const float* rt = rope + (size_t)qpos * 16;
                    const f32x4 c0 = *(const f32x4*)rt, c1 = *(const f32x4*)(rt + 4), s0 = *(const f32x4*)(rt + 8), s1 = *(const f32x4*)(rt + 12);
                    const float cs[8] = {c0.x, c0.y, c0.z, c0.w, c1.x, c1.y, c1.z, c1.w}, sn[8] = {s0.x, s0.y, s0.z, s0.w, s1.x, s1.y, s1.z, s1.w};
#pragma unroll
                    for (int e = 0; e < 4; ++e) { const float a0 = bflo(q0[e]) * cs[2 * e] + sg * bflo(oth[e]) * sn[2 * e], a1 = bfhi(q0[e]) * cs[2 * e + 1] + sg * bfhi(oth[e]) * sn[2 * e + 1]; r[e] = pk2(a0, a1); }
                    q0 = r; }
            }
            const bf16x8 qf0 = __builtin_bit_cast(bf16x8, q0), qf1 = __builtin_bit_cast(bf16x8, q1);
            const int lo = max(max(qpos - 127 - kbase, -kbase), 0), hi = min(qpos - kbase, nkeys - 1); const unsigned span = (unsigned)(hi - lo);
            const int ks_lo = SAMPLE ? 0 : ((wt & 7) >> 1), ks_hi = SAMPLE ? (NKT / 2 - 1) : (((wt & 7) + 8) >> 1);
            float mx = -INFINITY;
#pragma unroll 2
            for (int kt = 2 * ks_lo; kt <= 2 * ks_hi + 1; ++kt) { f32x4 acc = (f32x4){0.f, 0.f, 0.f, 0.f};
                const LAS bf16* kp = Ks + (16 * kt + l15) * KSTR + 8 * g;
                acc = mfma16(*(const LAS bf16x8*)kp, qf0, acc); acc = mfma16(*(const LAS bf16x8*)(kp + 32), qf1, acc);
#pragma unroll
                for (int r = 0; r < 4; ++r) { const int i = 16 * kt + 4 * g + r; const bool valid = (unsigned)(i - lo) <= span; mx = fmaxf(mx, valid ? acc[r] * 0.125f : -INFINITY); } }
            mx = fmaxf(mx, __shfl_xor(mx, 16)); mx = fmaxf(mx, __shfl_xor(mx, 32));
            const float sk = sinks[head]; mx = fmaxf(mx, sk);
            float sum = 0.f;
            f32x4 oacc[4];
#pragma unroll
            for (int nt = 0; nt < 4; ++nt) oacc[nt] = (f32x4){0.f, 0.f, 0.f, 0.f};
#pragma unroll 1
            for (int ks = ks_lo; ks <= ks_hi; ++ks) { float p[2][4];
#pragma unroll
                for (int hh = 0; hh < 2; ++hh) { const int kt = 2 * ks + hh; f32x4 acc = (f32x4){0.f, 0.f, 0.f, 0.f};
                    const LAS bf16* kp = Ks + (16 * kt + l15) * KSTR + 8 * g;
                    acc = mfma16(*(const LAS bf16x8*)kp, qf0, acc); acc = mfma16(*(const LAS bf16x8*)(kp + 32), qf1, acc);
#pragma unroll
                    for (int r = 0; r < 4; ++r) { const int i = 16 * kt + 4 * g + r; const bool valid = (unsigned)(i - lo) <= span; const float pv = valid ? __expf(acc[r] * 0.125f - mx) : 0.f; p[hh][r] = pv; sum += pv; } }
                u32x4 pw; pw.x = pk2(p[0][0], p[0][1]); pw.y = pk2(p[0][2], p[0][3]); pw.z = pk2(p[1][0], p[1][1]); pw.w = pk2(p[1][2], p[1][3]);
                const bf16x8 pa = __builtin_bit_cast(bf16x8, pw);
#pragma unroll
                for (int nt = 0; nt < 4; ++nt) { const LAS bf16* vp = VT + (16 * nt + l15) * VSTR + 32 * ks + 4 * g; const u32x2 lo = *(const LAS u32x2*)vp, hi = *(const LAS u32x2*)(vp + 16);
                    const u32x4 vw = (u32x4){lo.x, lo.y, hi.x, hi.y}; oacc[nt] = mfma16(pa, __builtin_bit_cast(bf16x8, vw), oacc[nt]); } }
            sum += __shfl_xor(sum, 16); sum += __shfl_xor(sum, 32);
            const float inv = 1.0f / (sum + __expf(sk - mx));
#pragma unroll
            for (int r = 0; r < 4; ++r) { const int qq = 4 * g + r; const float ir = __shfl(inv, qq); int h2, gr2, qp2; attn_rowmap<SAMPLE>(wt, qq, b, kvh, j, h2, gr2, qp2);
                bf16* op = O + (size_t)gr2 * D + h2 * 64 + l15;
#pragma unroll
                for (int nt = 0; nt < 4; ++nt) op[16 * nt] = (bf16)f2bf(oacc[nt][r] * ir); }
        }
    }
}

__device__ __forceinline__ void mlstm_a_units(const bf16* PROJ, const float* GATES, float* DCT, float* DN, float* AB, LAS unsigned char* lds, int tid, int wave, int lane, int bid, int nb) {
    LAS bf16* KT = (LAS bf16*)lds;
    LAS bf16* AVT = (LAS bf16*)(lds + 18432);
    LAS float* av = (LAS float*)(lds + 18432 + 36864);
    const int l15 = lane & 15, g = lane >> 4;
    for (int u = bid; u < 1024; u += nb) {
        const int bh = u >> 7, c = u & 127, b = bh >> 2, h = bh & 3; const int row0 = b * 8192 + c * 64;
        __syncthreads();
        u32x4 kreg[2], vreg[4];
#pragma unroll
        for (int i = 0; i < 2; ++i) { const int ci = tid + i * NTHR, s = ci >> 4, cc = ci & 15; kreg[i] = *(const u32x4*)(PROJ + (size_t)(row0 + s) * NPROJ + 512 + h * 128 + cc * 8); }
#pragma unroll
        for (int i = 0; i < 4; ++i) { const int ci = tid + i * NTHR, s = ci >> 5, cc = ci & 31; vreg[i] = *(const u32x4*)(PROJ + (size_t)(row0 + s) * NPROJ + 1024 + h * 256 + cc * 8); }
        if (wave == 0) { const float lf = GATES[(size_t)(row0 + lane) * 8 + 4 + h], ig = GATES[(size_t)(row0 + lane) * 8 + h];
            float bs = lf;
#pragma unroll
            for (int o = 1; o < 64; o <<= 1) { const float t = __shfl_up(bs, o); if (lane >= o) bs += t; }
            const float B = __shfl(bs, 63); const float e = B - bs + ig; const float A = wave_max(e);
            av[lane] = __expf(e - A) * KSCALE; if (lane == 0) { AB[u * 2] = A; AB[u * 2 + 1] = B; } }
        __syncthreads();
#pragma unroll
        for (int i = 0; i < 2; ++i) { const int ci = tid + i * NTHR, s = ci >> 4, cc = ci & 15; const u32x4 kv = kreg[i];
#pragma unroll
            for (int e = 0; e < 4; ++e) { KT[(cc * 8 + 2 * e) * 72 + s] = (bf16)(kv[e] & 0xffffu); KT[(cc * 8 + 2 * e + 1) * 72 + s] = (bf16)(kv[e] >> 16); } }
#pragma unroll
        for (int i = 0; i < 4; ++i) { const int ci = tid + i * NTHR, s = ci >> 5, cc = ci & 31; const u32x4 vv = vreg[i]; const float as = av[s];
#pragma unroll
            for (int e = 0; e < 4; ++e) { AVT[(cc * 8 + 2 * e) * 72 + s] = (bf16)f2bf(bflo(vv[e]) * as); AVT[(cc * 8 + 2 * e + 1) * 72 + s] = (bf16)f2bf(bfhi(vv[e]) * as); } }
        __syncthreads();
        if (wave == 7) {
            u32x4 w0 = (u32x4){0u, 0u, 0u, 0u}, w1 = (u32x4){0u, 0u, 0u, 0u};
            if (l15 == 0) { const LAS float* ap0 = av + 8 * g; const LAS float* ap1 = av + 32 + 8 * g;
                w0.x = pk2(ap0[0], ap0[1]); w0.y = pk2(ap0[2], ap0[3]); w0.z = pk2(ap0[4], ap0[5]); w0.w = pk2(ap0[6], ap0[7]);
                w1.x = pk2(ap1[0], ap1[1]); w1.y = pk2(ap1[2], ap1[3]); w1.z = pk2(ap1[4], ap1[5]); w1.w = pk2(ap1[6], ap1[7]); }
            const bf16x8 a0 = __builtin_bit_cast(bf16x8, w0), a1 = __builtin_bit_cast(bf16x8, w1);
#pragma unroll
            for (int nt = 0; nt < 8; ++nt) { f32x4 acc = (f32x4){0.f, 0.f, 0.f, 0.f};
                acc = mfma16(a0, *(const LAS bf16x8*)(KT + (16 * nt + l15) * 72 + 8 * g), acc); acc = mfma16(a1, *(const LAS bf16x8*)(KT + (16 * nt + l15) * 72 + 32 + 8 * g), acc);
                if (g == 0) DN[(size_t)u * 128 + 16 * nt + l15] = acc[0]; } }
#pragma unroll
        for (int mi = 0; mi < 2; ++mi) { const int mt = 2 * wave + mi;
            const bf16x8 a0 = *(const LAS bf16x8*)(AVT + (16 * mt + l15) * 72 + 8 * g), a1 = *(const LAS bf16x8*)(AVT + (16 * mt + l15) * 72 + 32 + 8 * g);
#pragma unroll
            for (int nt = 0; nt < 8; ++nt) { f32x4 acc = (f32x4){0.f, 0.f, 0.f, 0.f};
                acc = mfma16(*(const LAS bf16x8*)(KT + (16 * nt + l15) * 72 + 8 * g), a0, acc); acc = mfma16(*(const LAS bf16x8*)(KT + (16 * nt + l15) * 72 + 32 + 8 * g), a1, acc);
                *(f32x4*)(DCT + (size_t)u * 32768 + (16 * mt + l15) * 128 + 16 * nt + 4 * g) = acc; } }
    }
}
__device__ __forceinline__ void mlstm_b(const float* DCT, const float* DN, const float* AB, bf16* CTS, float* NS, float* MSb, float* oC, float* oN, float* oM, int gtid, int ngt) {
    for (int it = gtid; it < 131072; it += ngt) { const int dp = it & 63, v = (it >> 6) & 255, bh = it >> 14;
        float m = 0.f, c0 = 0.f, c1 = 0.f;
        const float* dsrc = DCT + (size_t)bh * 128 * 32768 + v * 128 + 2 * dp; bf16* cdst = CTS + (size_t)bh * 128 * 32768 + v * 128 + 2 * dp; const float* ab = AB + bh * 256;
        for (int c = 0; c < 128; c += 16) { f32x2v d[16], abv[16];
#pragma unroll
            for (int i = 0; i < 16; ++i) { d[i] = *(const f32x2v*)(dsrc + (size_t)(c + i) * 32768); abv[i] = *(const f32x2v*)(ab + (c + i) * 2); }
#pragma unroll
            for (int i = 0; i < 16; ++i) { const float A = abv[i].x, B = abv[i].y; *(unsigned*)(cdst + (size_t)(c + i) * 32768) = pk2(c0, c1);
                const float mn = fmaxf(B + m, A); const float dec = __expf(B + m - mn), inj = __expf(A - mn); c0 = dec * c0 + inj * d[i].x; c1 = dec * c1 + inj * d[i].y; m = mn; } }
        oC[((size_t)bh * 128 + 2 * dp) * 256 + v] = c0; oC[((size_t)bh * 128 + 2 * dp + 1) * 256 + v] = c1; }
    for (int it = gtid; it < 1024; it += ngt) { const int d = it & 127, bh = it >> 7; float m = 0.f, n = 0.f; const float* ab = AB + bh * 256;
        for (int c0 = 0; c0 < 128; c0 += 16) { float dn[16]; f32x2v abv[16];
#pragma unroll
            for (int i = 0; i < 16; ++i) { dn[i] = DN[(size_t)(bh * 128 + c0 + i) * 128 + d]; abv[i] = *(const f32x2v*)(ab + (c0 + i) * 2); }
#pragma unroll
            for (int i = 0; i < 16; ++i) { const int c = c0 + i; NS[(size_t)(bh * 129 + c) * 128 + d] = n; if (d == 0) MSb[bh * 129 + c] = m; const float A = abv[i].x, B = abv[i].y;
                const float mn = fmaxf(B + m, A); const float dec = __expf(B + m - mn), inj = __expf(A - mn); n = dec * n + inj * dn[i]; m = mn; } }
        oN[bh * 128 + d] = n; if (d == 0) oM[bh] = m; }
}
__device__ __forceinline__ void mlstm_c_units(const bf16* PROJ, const float* GATES, const bf16* CTS, const float* NS, const float* MSb, const float* hnorm, bf16* HH, LAS unsigned char* lds, int tid, int wave, int lane, int bid, int nb) {
    LAS bf16* Qs = (LAS bf16*)lds;
    LAS bf16* Ks = (LAS bf16*)(lds + 17408);
    LAS bf16* VT = (LAS bf16*)(lds + 34816);
    LAS bf16* Ps = (LAS bf16*)(lds + 71680);
    LAS float* sc = (LAS float*)(lds + 80896);
    LAS float *s_u = sc, *s_M = sc + 64, *s_w = sc + 128, *s_e = sc + 192, *s_dens = sc + 256, *s_qn = sc + 320, *s_ss = sc + 384, *s_rden = sc + 448;
    const int l15 = lane & 15, g = lane >> 4;
    for (int u = bid; u < 1024; u += nb) {
        const int bh = u >> 7, c = u & 127, b = bh >> 2, h = bh & 3; const int row0 = b * 8192 + c * 64;
        __syncthreads();
        u32x4 qreg[2], kreg[2], vreg[4];
#pragma unroll
        for (int i = 0; i < 2; ++i) { const int ci = tid + i * NTHR, s = ci >> 4, cc = ci & 15; const bf16* rp = PROJ + (size_t)(row0 + s) * NPROJ + h * 128 + cc * 8; qreg[i] = *(const u32x4*)rp; kreg[i] = *(const u32x4*)(rp + 512); }
#pragma unroll
        for (int i = 0; i < 4; ++i) { const int ci = tid + i * NTHR, s = ci >> 5, cc = ci & 31; vreg[i] = *(const u32x4*)(PROJ + (size_t)(row0 + s) * NPROJ + 1024 + h * 256 + cc * 8); }
        if (wave == 0) { const float lf = GATES[(size_t)(row0 + lane) * 8 + 4 + h], ig = GATES[(size_t)(row0 + lane) * 8 + h];
            float bs = lf;
#pragma unroll
            for (int o = 1; o < 64; o <<= 1) { const float t = __shfl_up(bs, o); if (lane >= o) bs += t; }
            const float uu = ig - bs; float U = uu;
#pragma unroll
            for (int o = 1; o < 64; o <<= 1) { const float t = __shfl_up(U, o); if (lane >= o) U = fmaxf(U, t); }
            const float mc = MSb[bh * 129 + c]; const float Mt = fmaxf(mc, U);
            s_u[lane] = uu; s_M[lane] = Mt; s_w[lane] = __expf(mc - Mt); s_e[lane] = __expf(-(bs + Mt)); s_dens[lane] = 0.f; s_ss[lane] = 0.f; }
#pragma unroll
        for (int i = 0; i < 2; ++i) { const int ci = tid + i * NTHR, s = ci >> 4, cc = ci & 15; *(LAS u32x4*)(Qs + s * 136 + cc * 8) = qreg[i]; *(LAS u32x4*)(Ks + s * 136 + cc * 8) = kreg[i]; }
#pragma unroll
        for (int i = 0; i < 4; ++i) { const int ci = tid + i * NTHR, s = ci >> 5, cc = ci & 31; const u32x4 vv = vreg[i];
#pragma unroll
            for (int e = 0; e < 4; ++e) { VT[(cc * 8 + 2 * e) * 72 + s] = (bf16)(vv[e] & 0xffffu); VT[(cc * 8 + 2 * e + 1) * 72 + s] = (bf16)(vv[e] >> 16); } }
        f32x4 hnv[2];
#pragma unroll
        for (int nl = 0; nl < 2; ++nl) hnv[nl] = *(const f32x4*)(hnorm + h * 256 + 16 * (2 * wave + nl) + 4 * g);
        u32x2 og[4][2];
#pragma unroll
        for (int mt = 0; mt < 4; ++mt)
#pragma unroll
            for (int nl = 0; nl < 2; ++nl) og[mt][nl] = *(const u32x2*)(PROJ + (size_t)(row0 + 16 * mt + l15) * NPROJ + 2048 + h * 256 + 16 * (2 * wave + nl) + 4 * g);
        __syncthreads();
#pragma unroll
        for (int ti2 = 0; ti2 < 2; ++ti2) { const int tile = 2 * wave + ti2, ti = tile >> 2, si = tile & 3;
            f32x4 acc = (f32x4){0.f, 0.f, 0.f, 0.f};
            if (si <= ti) {
#pragma unroll
                for (int ks = 0; ks < 4; ++ks) acc = mfma16(*(const LAS bf16x8*)(Qs + (16 * ti + l15) * 136 + 32 * ks + 8 * g), *(const LAS bf16x8*)(Ks + (16 * si + l15) * 136 + 32 * ks + 8 * g), acc); }
            const int s = 16 * si + l15; const float us = s_u[s];
#pragma unroll
            for (int r = 0; r < 4; ++r) { const int t = 16 * ti + 4 * g + r; float p = (s <= t) ? acc[r] * KSCALE * __expf(us - s_M[t]) : 0.f;
                Ps[t * 72 + s] = (bf16)f2bf(p);
                p += __shfl_xor(p, 1); p += __shfl_xor(p, 2); p += __shfl_xor(p, 4); p += __shfl_xor(p, 8);
                if (l15 == 0) __hip_atomic_fetch_add(s_dens + t, p, __ATOMIC_RELAXED, __HIP_MEMORY_SCOPE_WORKGROUP); } }
        {   const int t = tid >> 3, part = tid & 7; float acc = 0.f; const float* np = NS + (size_t)(bh * 129 + c) * 128 + part * 16;
#pragma unroll
            for (int dd = 0; dd < 16; ++dd) acc += bf2f(Qs[t * 136 + part * 16 + dd]) * np[dd];
            acc += __shfl_xor(acc, 1); acc += __shfl_xor(acc, 2); acc += __shfl_xor(acc, 4);
            if (part == 0) s_qn[t] = acc; }
        __syncthreads();
        if (tid < 64) { const float den = s_dens[tid] + s_w[tid] * s_qn[tid]; s_rden[tid] = 1.0f / fmaxf(fabsf(den), s_e[tid]); }
        __syncthreads();
        f32x4 a1[4][2];
#pragma unroll
        for (int nl = 0; nl < 2; ++nl) { const int nt = 2 * wave + nl; f32x4 acc[4];
#pragma unroll
            for (int mt = 0; mt < 4; ++mt) acc[mt] = (f32x4){0.f, 0.f, 0.f, 0.f};
            const bf16* cp = CTS + ((size_t)u * 256 + 16 * nt + l15) * 128 + 8 * g;
#pragma unroll
            for (int ks = 0; ks < 4; ++ks) { const bf16x8 afr = *(const bf16x8*)(cp + 32 * ks);
#pragma unroll
                for (int mt = 0; mt < 4; ++mt) acc[mt] = mfma16(afr, *(const LAS bf16x8*)(Qs + (16 * mt + l15) * 136 + 32 * ks + 8 * g), acc[mt]); }
#pragma unroll
            for (int mt = 0; mt < 4; ++mt) acc[mt] *= s_w[16 * mt + l15];
#pragma unroll
            for (int ks = 0; ks < 2; ++ks) { const bf16x8 afr = *(const LAS bf16x8*)(VT + (16 * nt + l15) * 72 + 32 * ks + 8 * g);
#pragma unroll
                for (int mt = 0; mt < 4; ++mt) acc[mt] = mfma16(afr, *(const LAS bf16x8*)(Ps + (16 * mt + l15) * 72 + 32 * ks + 8 * g), acc[mt]); }
#pragma unroll
            for (int mt = 0; mt < 4; ++mt) a1[mt][nl] = acc[mt] * s_rden[16 * mt + l15];
            asm volatile("" ::: "memory"); }
#pragma unroll
        for (int mt = 0; mt < 4; ++mt) { const int t = 16 * mt + l15; float q = 0.f;
#pragma unroll
            for (int nl = 0; nl < 2; ++nl) { const f32x4 hv = a1[mt][nl]; q += (hv[0] * hv[0] + hv[1] * hv[1]) + (hv[2] * hv[2] + hv[3] * hv[3]); }
            q += __shfl_xor(q, 16); q += __shfl_xor(q, 32);
            if (g == 0) __hip_atomic_fetch_add(s_ss + t, q, __ATOMIC_RELAXED, __HIP_MEMORY_SCOPE_WORKGROUP); }
        __syncthreads();
#pragma unroll
        for (int mt = 0; mt < 4; ++mt) { const int t = 16 * mt + l15; const float rs = 1.0f / sqrtf(s_ss[t] * (1.0f / 256.0f) + EPS);
#pragma unroll
            for (int nl = 0; nl < 2; ++nl) { const int v0 = 16 * (2 * wave + nl) + 4 * g; const u32x2 ow = og[mt][nl]; const f32x4 hn = hnv[nl]; const f32x4 hv = a1[mt][nl];
                const float o0 = bflo(ow.x), o1 = bfhi(ow.x), o2 = bflo(ow.y), o3 = bfhi(ow.y);
                u32x2 w; w.x = pk2(hv[0] * rs * hn[0] / (1.0f + __expf(-o0)), hv[1] * rs * hn[1] / (1.0f + __expf(-o1))); w.y = pk2(hv[2] * rs * hn[2] / (1.0f + __expf(-o2)), hv[3] * rs * hn[3] / (1.0f + __expf(-o3)));
                *(u32x2*)(HH + (size_t)(row0 + t) * D + h * 256 + v0) = w; } }
    }
}
__device__ __forceinline__ void mlstm_sample_units(const bf16* PROJ, const float* GATES, const float* C0, const float* n0, const float* m0, const float* hnorm, bf16* HH,
                                                   float* oC, float* oN, float* oM, LAS unsigned char* lds, int tid, int wave, int lane, int bid, int nb) {
    LAS float* q = (LAS float*)lds;
    LAS float* k = q + 1024;
    LAS float* vv = k + 1024;
    LAS float* part = vv + 2048;
    LAS float* sc = part + 16384;
    LAS float *s_S = sc, *s_u = sc + 64, *s_M = sc + 72, *s_w = sc + 80, *s_e = sc + 88, *s_a = sc + 96, *s_qn = sc + 104, *s_ss = sc + 112, *s_rden = sc + 120, *s_misc = sc + 128;
    for (int u = bid; u < 512; u += nb) {
        const int b = u >> 2, h = u & 3; const int row0 = MP + b * 8; const int bh = b * 4 + h;
        __syncthreads();
        if (tid < 128) { const int t = tid >> 4, cc = tid & 15; const u32x4 w = *(const u32x4*)(PROJ + (size_t)(row0 + t) * NPROJ + h * 128 + cc * 8);
#pragma unroll
            for (int e = 0; e < 4; ++e) { q[t * 128 + cc * 8 + 2 * e] = bflo(w[e]); q[t * 128 + cc * 8 + 2 * e + 1] = bfhi(w[e]); } }
        else if (tid < 256) { const int i = tid - 128, t = i >> 4, cc = i & 15; const u32x4 w = *(const u32x4*)(PROJ + (size_t)(row0 + t) * NPROJ + 512 + h * 128 + cc * 8);
#pragma unroll
            for (int e = 0; e < 4; ++e) { k[t * 128 + cc * 8 + 2 * e] = bflo(w[e]) * KSCALE; k[t * 128 + cc * 8 + 2 * e + 1] = bfhi(w[e]) * KSCALE; } }
        else { const int i = tid - 256, t = i >> 5, cc = i & 31; const u32x4 w = *(const u32x4*)(PROJ + (size_t)(row0 + t) * NPROJ + 1024 + h * 256 + cc * 8);
#pragma unroll
            for (int e = 0; e < 4; ++e) { vv[t * 256 + cc * 8 + 2 * e] = bflo(w[e]); vv[t * 256 + cc * 8 + 2 * e + 1] = bfhi(w[e]); } }
        if (tid == 0) { float bs[8], ig[8]; float run = 0.f;
#pragma unroll
            for (int t = 0; t < 8; ++t) { run += GATES[(size_t)(row0 + t) * 8 + 4 + h]; bs[t] = run; ig[t] = GATES[(size_t)(row0 + t) * 8 + h]; }
            const float m0v = m0[bh]; const float B = bs[7]; float A = -INFINITY;
#pragma unroll
            for (int t = 0; t < 8; ++t) A = fmaxf(A, B - bs[t] + ig[t]);
            const float mnew = fmaxf(B + m0v, A); float U = -INFINITY;
#pragma unroll
            for (int t = 0; t < 8; ++t) { const float uu = ig[t] - bs[t]; U = fmaxf(U, uu); const float Mt = fmaxf(m0v, U);
                s_u[t] = uu; s_M[t] = Mt; s_w[t] = __expf(m0v - Mt); s_e[t] = __expf(-(bs[t] + Mt)); s_a[t] = __expf(B - bs[t] + ig[t] - mnew); s_ss[t] = 0.f; }
            s_misc[0] = __expf(B + m0v - mnew); oM[bh] = mnew; }
        __syncthreads();
        const float decay = s_misc[0];
        if (tid < 64) { const int t = tid >> 3, s = tid & 7; float dot = 0.f;
            for (int d = 0; d < 128; ++d) dot += q[t * 128 + d] * k[s * 128 + d];
            s_S[t * 8 + s] = (s <= t) ? dot * __expf(s_u[s] - s_M[t]) : 0.f; }
        else if (tid < 72) { const int t = tid - 64; float dot = 0.f;
            for (int d = 0; d < 128; ++d) dot += q[t * 128 + d] * n0[(size_t)bh * 128 + d];
            s_qn[t] = dot; }
        else if (tid >= 128 && tid < 256) { const int d = tid - 128; float nn = decay * n0[(size_t)bh * 128 + d];
#pragma unroll
            for (int s = 0; s < 8; ++s) nn += s_a[s] * k[s * 128 + d];
            oN[(size_t)bh * 128 + d] = nn; }
        __syncthreads();
        if (tid < 8) { float den = s_w[tid] * s_qn[tid];
#pragma unroll
            for (int s = 0; s < 8; ++s) den += s_S[tid * 8 + s];
            s_rden[tid] = 1.0f / fmaxf(fabsf(den), s_e[tid]); }
        {
            const int v0 = 4 * (tid & 63), dg = tid >> 6; f32x4 acc[8], vr[8];
#pragma unroll
            for (int s = 0; s < 8; ++s) { acc[s] = (f32x4){0.f, 0.f, 0.f, 0.f}; vr[s] = *(const LAS f32x4*)(vv + s * 256 + v0) * s_a[s]; }
            const float* cp = C0 + ((size_t)bh * 128 + dg * 16) * 256 + v0; float* op = oC + ((size_t)bh * 128 + dg * 16) * 256 + v0;
#pragma unroll
            for (int d0 = 0; d0 < 16; d0 += 8) { f32x4 cvb[8];
#pragma unroll
                for (int i = 0; i < 8; ++i) cvb[i] = *(const f32x4*)(cp + (size_t)(d0 + i) * 256);
#pragma unroll
                for (int i = 0; i < 8; ++i) { const int d = dg * 16 + d0 + i; const f32x4 cv = cvb[i]; f32x4 cn = cv * decay;
#pragma unroll
                    for (int s = 0; s < 8; ++s) { acc[s] += cv * q[s * 128 + d]; cn += vr[s] * k[s * 128 + d]; }
                    *(f32x4*)(op + (size_t)(d0 + i) * 256) = cn; } }
#pragma unroll
            for (int t = 0; t < 8; ++t) *(LAS f32x4*)(part + (dg * 8 + t) * 256 + v0) = acc[t]; }
        __syncthreads();
        {   const int v = tid & 255, th = tid >> 8; float hv[4];
            float ov[4]; const float hnw = hnorm[h * 256 + v];
#pragma unroll
            for (int tt = 0; tt < 4; ++tt) ov[tt] = bf2f(PROJ[(size_t)(row0 + th * 4 + tt) * NPROJ + 2048 + h * 256 + v]);
#pragma unroll
            for (int tt = 0; tt < 4; ++tt) { const int t = th * 4 + tt; float ps = 0.f;
#pragma unroll
                for (int dg = 0; dg < 8; ++dg) ps += part[(dg * 8 + t) * 256 + v];
                float num = s_w[t] * ps;
#pragma unroll
                for (int s = 0; s < 8; ++s) num += s_S[t * 8 + s] * vv[s * 256 + v];
                hv[tt] = num * s_rden[t]; const float qv = wave_sum(hv[tt] * hv[tt]);
                if (lane == 0) __hip_atomic_fetch_add(s_ss + t, qv, __ATOMIC_RELAXED, __HIP_MEMORY_SCOPE_WORKGROUP); }
            __syncthreads();
#pragma unroll
            for (int tt = 0; tt < 4; ++tt) { const int t = th * 4 + tt; const float rs = 1.0f / sqrtf(s_ss[t] * (1.0f / 256.0f) + EPS);
                const float o = ov[tt];
                HH[(size_t)(row0 + t) * D + h * 256 + v] = (bf16)f2bf(hv[tt] * rs * hnw / (1.0f + __expf(-o))); } }
    }
}

template <class Epi>
__device__ __forceinline__ void run_gemm(LAS unsigned char* lds, const bf16* A, const bf16* Bt, int M, int N, int K, const Epi& E, int tid, int bid, int nb) {
    pg8::Gemm g{A, Bt, M, N, K, K / 64}; pg8::StaticOrder S; S.init(M, N, nb, bid);
    pg8::gemm_phase<Epi, pg8::StaticOrder, false, true>(lds, g, S, E, tid);
}
template <int NS>
__device__ __forceinline__ void run_gemm_sample_split(LAS unsigned char* lds, const bf16* A, const bf16* Bt, int K, float* PART, const float* bias, float scale, int tid, int bid, int nb) {
    const int item = bid; const bool has = item < 16 * NS; const int tile = item / NS, ks = item % NS; const int klen = K / NS;
    pg8::Gemm g{A + (size_t)ks * klen, Bt + (size_t)ks * klen, MT, D, K, klen / 64}; pg8::OneUnit S{MP / 256 + (tile >> 2), tile & 3, has};
    pg8::EpiPartial E{PART + (size_t)ks * 1048576, bias, scale, ks == 0};
    pg8::gemm_phase<pg8::EpiPartial, pg8::OneUnit, false, true>(lds, g, S, E, tid);
}

#define XB_TMO      128
#define XB_XCNT(j)  (256  + 64 * (j))
#define XB_XSUB(j)  (1280 + 64 * (j))
#define XB_XGEN(j)  (2304 + 64 * (j))
#define XB_TOP      3328
#define XB_TOPGEN   3392
#define XCD_BAR_WORDS 3456
#define XB_SPIN_CAP (1u << 18)

__device__ __forceinline__ unsigned xb_ld(unsigned* p)              { return __hip_atomic_load(p, __ATOMIC_RELAXED, __HIP_MEMORY_SCOPE_AGENT); }
__device__ __forceinline__ unsigned xb_add(unsigned* p, unsigned v) { return __hip_atomic_fetch_add(p, v, __ATOMIC_RELAXED, __HIP_MEMORY_SCOPE_AGENT); }
__device__ __forceinline__ unsigned xb_xcc_id() { return (unsigned)__builtin_amdgcn_s_getreg((3 << 11) | 20) & 0xFu; }
#define XB_SPIN(cond, bar) do { unsigned _sp = 0; while (cond) { __builtin_amdgcn_s_sleep(1); \
    if ((++_sp & 255u) == 0u) { if (xb_ld(&(bar)[XB_TMO])) break; if (_sp > XB_SPIN_CAP) { atomicAdd(&(bar)[XB_TMO], 1u); break; } } } } while (0)

struct XcdBarrier {
    unsigned* bar; unsigned x;
    volatile LAS unsigned* st;
};

__device__ __forceinline__ XcdBarrier xcd_barrier_post(unsigned* bar, volatile LAS unsigned* st) {
    XcdBarrier b; b.bar = bar; b.x = xb_xcc_id(); b.st = st;
    if (threadIdx.x == 0) (void)xb_add(&bar[XB_XCNT(b.x)], 1u);
    return b;
}
__device__ __forceinline__ void xcd_barrier_complete(unsigned* bar, unsigned x, unsigned& nloc, unsigned& nx) {
    const unsigned G = gridDim.x * gridDim.y * gridDim.z;
    unsigned sum, cnt, mine, sp = 0u;
    for (;;) {
        sum = 0u; cnt = 0u; mine = 0u;
#pragma unroll
        for (unsigned j = 0; j < 16; ++j) { const unsigned c = xb_ld(&bar[XB_XCNT(j)]); sum += c; cnt += (c > 0u) ? 1u : 0u; mine = (j == x) ? c : mine; }
        if (sum == G) break;
        __builtin_amdgcn_s_sleep(1);
        if ((++sp & 255u) == 0u) { if (xb_ld(&bar[XB_TMO])) break; if (sp > XB_SPIN_CAP) { atomicAdd(&bar[XB_TMO], 1u); break; } }
    }
    nloc = mine > 0u ? mine : 1u; nx = cnt > 0u ? cnt : 1u;
}

__device__ __forceinline__ void xcd_barrier(const XcdBarrier& b) {
    asm volatile("s_waitcnt vmcnt(0)" ::: "memory");
    __syncthreads();
    if (threadIdx.x == 0) {
        unsigned* bar = b.bar;
        __builtin_amdgcn_s_waitcnt(0);
        unsigned nloc = b.st[0], nx = b.st[1];
        if (nloc == 0u) { xcd_barrier_complete(bar, b.x, nloc, nx); b.st[0] = nloc; b.st[1] = nx; }
        const unsigned old = xb_add(&bar[XB_XSUB(b.x)], 1u);
        const unsigned gen = old / nloc;
        if (old + 1u == (gen + 1u) * nloc) {
            __builtin_amdgcn_fence(__ATOMIC_RELEASE, "agent");
            asm volatile("s_waitcnt vmcnt(0)" ::: "memory");
            const unsigned og = xb_add(&bar[XB_TOP], 1u);
            const unsigned tg = og / nx;
            if (og + 1u == (tg + 1u) * nx) xb_add(&bar[XB_TOPGEN], 1u);
            else XB_SPIN(xb_ld(&bar[XB_TOPGEN]) == tg, bar);
            __builtin_amdgcn_fence(__ATOMIC_ACQUIRE, "agent");
            xb_add(&bar[XB_XGEN(b.x)], 1u);
            asm volatile("s_waitcnt vmcnt(0)" ::: "memory");
        } else {
            XB_SPIN(xb_ld(&bar[XB_XGEN(b.x)]) == gen, bar);
            __builtin_amdgcn_fence(__ATOMIC_ACQUIRE, "agent");
            asm volatile("s_waitcnt vmcnt(0)" ::: "memory");
        }
    }
    __syncthreads();
}

#define PV int tid = threadIdx.x; int bid = blockIdx.x; asm volatile("" : "+v"(tid)); asm volatile("" : "+s"(bid)); const int nb = gridDim.x; \
    ArgsP ap = (ArgsP)__builtin_amdgcn_kernarg_segment_ptr(); asm volatile("" : "+s"(ap)); unsigned char* ws = ap->ws; float* XRES = ap->out; (void)ws; (void)XRES; \
    const int lane = tid & 63, wave = __builtin_amdgcn_readfirstlane(tid >> 6); const int gw = bid * 8 + wave, ngw = nb * 8, gtid = bid * NTHR + tid, ngt = nb * NTHR; \
    (void)lane; (void)wave; (void)gw; (void)ngw; (void)gtid; (void)ngt;
#define XBAR() do { XcdBarrier b_; b_.bar = (unsigned*)(((ArgsP)__builtin_amdgcn_kernarg_segment_ptr())->ws); b_.x = xb_xcc_id(); b_.st = (volatile LAS unsigned*)(lds + LDS_BYTES - 64); xcd_barrier(b_); } while (0)
#ifdef PROBE_SYNC
#define GSYNC() do { XBAR(); XBAR(); } while (0)
#else
#define GSYNC() XBAR()
#endif
#define REPX for (int rep_ = 0; rep_ < 2; ++rep_)
#ifdef PROBE_MA
#define DUP_MA(...) __VA_ARGS__ __VA_ARGS__
#else
#define DUP_MA(...) __VA_ARGS__
#endif
#ifdef PROBE_MB
#define DUP_MB(...) __VA_ARGS__ __VA_ARGS__
#else
#define DUP_MB(...) __VA_ARGS__
#endif
#ifdef PROBE_MC
#define DUP_MC(...) __VA_ARGS__ __VA_ARGS__
#else
#define DUP_MC(...) __VA_ARGS__
#endif
#ifdef PROBE_P0
#define REP_P0 REPX
#else
#define REP_P0
#endif
#ifdef PROBE_MLSTM
#define REP_ML REPX
#else
#define REP_ML
#endif
#ifdef PROBE_ATTN
#define REP_AT REPX
#else
#define REP_AT
#endif
#ifdef PROBE_GEMM
#define REP_GE REPX
#else
#define REP_GE
#endif
#define XN_ ((bf16*)(ws + WS_XN))
#define XN2_ ((bf16*)(ws + WS_XN2))
#define ACT_ ((bf16*)(ws + WS_ACT))
#define PROJ_ ((bf16*)(ws + WS_ACT))
#define GATES_ ((float*)(ws + WS_GATES))
#define AB_ ((float*)(ws + WS_AB))
#define MSb_ ((float*)(ws + WS_MS))
#define NS_ ((float*)(ws + WS_NS))
#define DN_ ((float*)(ws + WS_DN))
#define DCT_ ((float*)(ws + WS_DCT))
#define CTS_ ((bf16*)(ws + WS_CTS))
#define QB_ ((bf16*)(ws + WS_QB))
#define KVRAW_ ((float*)(ws + WS_KVRAW))
#define PART_ ((float*)(ws + WS_PART))

template <int l>
__device__ __forceinline__ void layer_body(LAS unsigned char* lds) {
        if (l == 2) REP_GE { PV pg8::EpiF32 E{KVRAW_, 512, ap->in[18]}; run_gemm(lds, XN2_, (const bf16*)(ws + WS_WKV), MT, 512, D, E, tid, bid, nb); }
        REP_GE { PV pg8::EpiSwiGLU E{ACT_, DFF}; run_gemm(lds, XN_, (const bf16*)(ws + WS_WGU + (size_t)(2 * l) * SZ_WGU), MT, NGU, D, E, tid, bid, nb); }
        GSYNC();
        { PV pg8::EpiResid E{XRES, D, nullptr, 0.5f}; run_gemm(lds, ACT_, (const bf16*)(ws + WS_WD + (size_t)(2 * l) * SZ_WD), MP, D, DFF, E, tid, bid, nb); }
        { PV run_gemm_sample_split<11>(lds, ACT_, (const bf16*)(ws + WS_WD + (size_t)(2 * l) * SZ_WD), DFF, PART_, nullptr, 0.5f, tid, bid, nb); }
#ifdef PROBE_DOWN
        { PV pg8::EpiResid E{XRES, D, nullptr, 0.0f}; run_gemm(lds, ACT_, (const bf16*)(ws + WS_WD + (size_t)(2 * l) * SZ_WD), MP, D, DFF, E, tid, bid, nb); }
        { PV run_gemm_sample_split<11>(lds, ACT_, (const bf16*)(ws + WS_WD + (size_t)(2 * l) * SZ_WD), DFF, PART_, nullptr, 0.5f, tid, bid, nb); }
#endif
        GSYNC();
        if (l < 2) { PV
            LAS float* wg = (LAS float*)(lds + 128);
            for (int i = tid; i < 8192; i += NTHR) wg[i] = ap->in[12][(size_t)l * D * APROJ + (size_t)(i >> 3) * APROJ + 3072 + (i & 7)];
            __syncthreads();
            norm_phase(XRES, XRES + (size_t)MP * D, nullptr, ap->in[11] + l * D, XN_, nullptr, nullptr, nullptr, wg, ap->in[13] + l * 8, GATES_, PART_, 11, XRES, gw, ngw, lane);
        } else {
            { PV norm_phase(XRES, XRES + (size_t)MP * D, nullptr, ap->in[11] + l * D, XN_, nullptr, nullptr, nullptr, nullptr, nullptr, nullptr, PART_, 11, XRES, gw, ngw, lane); }
#ifdef PROBE_NORM
        { PV norm_phase(XRES, XRES + (size_t)MP * D, nullptr, ap->in[11] + l * D, XN_, nullptr, nullptr, nullptr, nullptr, nullptr, nullptr, nullptr, 0, nullptr, gw, ngw, lane); }
#endif
            if (l == 2) { PV kv_finalize(ap, gtid, ngt); }
        }
        GSYNC();
        if (l < 2) {
            REP_GE { PV pg8::EpiBf16B E{PROJ_, NPROJ, nullptr}; run_gemm(lds, XN_, (const bf16*)(ws + WS_WIN + (size_t)l * SZ_WIN), MT, NPROJ, D, E, tid, bid, nb); }
            GSYNC();
            DUP_MA({ PV mlstm_a_units(PROJ_, GATES_, DCT_, DN_, AB_, lds, tid, wave, lane, bid, nb); })
            DUP_MA({ PV mlstm_sample_units(PROJ_, GATES_, ap->in[2] + (size_t)l * 128 * 4 * 128 * 256, ap->in[3] + (size_t)l * 128 * 4 * 128, ap->in[4] + (size_t)l * 512, ap->in[14] + l * D, XN_,
                               ap->out + OFF_SC + (size_t)l * 128 * 4 * 128 * 256, ap->out + OFF_SN + (size_t)l * 128 * 4 * 128, ap->out + OFF_SM + (size_t)l * 512, lds, tid, wave, lane, bid, nb); })
            GSYNC();
            DUP_MB({ PV mlstm_b(DCT_, DN_, AB_, CTS_, NS_, MSb_, ap->out + OFF_PC + (size_t)l * 262144, ap->out + OFF_PN + (size_t)l * 1024, ap->out + OFF_PM + (size_t)l * 8, gtid, ngt); })
            GSYNC();
            DUP_MC({ PV mlstm_c_units(PROJ_, GATES_, CTS_, NS_, MSb_, ap->in[14] + l * D, XN_, lds, tid, wave, lane, bid, nb); })
            GSYNC();
            { PV pg8::EpiResid E{XRES, D, nullptr, 1.0f}; run_gemm(lds, XN_, (const bf16*)(ws + WS_WOUT + (size_t)l * SZ_SQ), MP, D, D, E, tid, bid, nb); }
            { PV run_gemm_sample_split<4>(lds, XN_, (const bf16*)(ws + WS_WOUT + (size_t)l * SZ_SQ), D, PART_, nullptr, 1.0f, tid, bid, nb); }
        } else {
            const int j = l - 2;
            REP_GE { PV pg8::EpiBf16B E{QB_, D, ap->in[20] + j * D}; run_gemm(lds, XN_, (const bf16*)(ws + WS_WQ + (size_t)j * SZ_SQ), MP, D, D, E, tid, bid, nb); }
            { PV run_gemm_sample_split<4>(lds, XN_, (const bf16*)(ws + WS_WQ + (size_t)j * SZ_SQ), D, PART_, ap->in[20] + j * D, 1.0f, tid, bid, nb); }
            GSYNC();
            REP_AT { PV attn_units<16, false>(QB_, (const bf16*)(ws + WS_KB), (const bf16*)(ws + WS_VB), XN_, ap->in[21] + j * 16, (const float*)(ws + WS_ROPE), PART_, lds, tid, wave, lane, bid, nb); }
            REP_AT { PV attn_units<10, true>(QB_, (const bf16*)(ws + WS_SKB), (const bf16*)(ws + WS_SVB), XN_, ap->in[21] + j * 16, (const float*)(ws + WS_ROPE), PART_, lds, tid, wave, lane, bid, nb); }
            GSYNC();
            { PV pg8::EpiResid E{XRES, D, ap->in[23] + j * D, 1.0f}; run_gemm(lds, XN_, (const bf16*)(ws + WS_WO + (size_t)j * SZ_SQ), MP, D, D, E, tid, bid, nb); }
            { PV run_gemm_sample_split<4>(lds, XN_, (const bf16*)(ws + WS_WO + (size_t)j * SZ_SQ), D, PART_, ap->in[23] + j * D, 1.0f, tid, bid, nb); }
        }
        GSYNC();
        { PV norm_phase(XRES, XRES + (size_t)MP * D, nullptr, ap->in[7] + (2 * l + 1) * D, XN_, nullptr, nullptr, nullptr, nullptr, nullptr, nullptr, PART_, 4, XRES, gw, ngw, lane); }
#ifdef PROBE_NORM
        { PV norm_phase(XRES, XRES + (size_t)MP * D, nullptr, ap->in[7] + (2 * l + 1) * D, XN_, nullptr, nullptr, nullptr, nullptr, nullptr, nullptr, nullptr, 0, nullptr, gw, ngw, lane); }
#endif
        GSYNC();
        REP_GE { PV pg8::EpiSwiGLU E{ACT_, DFF}; run_gemm(lds, XN_, (const bf16*)(ws + WS_WGU + (size_t)(2 * l + 1) * SZ_WGU), MT, NGU, D, E, tid, bid, nb); }
        GSYNC();
        { PV pg8::EpiResid E{XRES, D, nullptr, 0.5f}; run_gemm(lds, ACT_, (const bf16*)(ws + WS_WD + (size_t)(2 * l + 1) * SZ_WD), MP, D, DFF, E, tid, bid, nb); }
        { PV run_gemm_sample_split<11>(lds, ACT_, (const bf16*)(ws + WS_WD + (size_t)(2 * l + 1) * SZ_WD), DFF, PART_, nullptr, 0.5f, tid, bid, nb); }
#ifdef PROBE_DOWN
        { PV pg8::EpiResid E{XRES, D, nullptr, 0.0f}; run_gemm(lds, ACT_, (const bf16*)(ws + WS_WD + (size_t)(2 * l + 1) * SZ_WD), MP, D, DFF, E, tid, bid, nb); }
        { PV run_gemm_sample_split<11>(lds, ACT_, (const bf16*)(ws + WS_WD + (size_t)(2 * l + 1) * SZ_WD), DFF, PART_, nullptr, 0.5f, tid, bid, nb); }
#endif
        GSYNC();
        if (l < 3) { PV norm_phase(XRES, XRES + (size_t)MP * D, nullptr, ap->in[7] + (2 * l + 2) * D, XN_, ap->in[16], (l == 1) ? XN2_ : nullptr, nullptr, nullptr, nullptr, nullptr, PART_, 11, XRES, gw, ngw, lane); }
#ifdef PROBE_NORM
        if (l < 3) { PV norm_phase(XRES, XRES + (size_t)MP * D, nullptr, ap->in[7] + (2 * l + 2) * D, XN_, ap->in[16], (l == 1) ? XN2_ : nullptr, nullptr, nullptr, nullptr, nullptr, nullptr, 0, nullptr, gw, ngw, lane); }
#endif
        else { PV norm_phase(XRES, XRES + (size_t)MP * D, nullptr, ap->in[24], nullptr, nullptr, nullptr, XRES, nullptr, nullptr, nullptr, PART_, 11, nullptr, gw, ngw, lane); }
        if (l < 3) GSYNC();
}

__global__ void __launch_bounds__(NTHR, 2) mk_fwd(Args a) {
    extern __shared__ __attribute__((aligned(16))) unsigned char lds_raw[];
    LAS unsigned char* lds = (LAS unsigned char*)lds_raw;
    cg::grid_group grid = cg::this_grid();
    if (a.ws == nullptr) grid.sync();
    volatile LAS unsigned* bst = (volatile LAS unsigned*)(lds + LDS_BYTES - 64);
    if (threadIdx.x < 16) bst[threadIdx.x] = 0u;
    __syncthreads();
    (void)xcd_barrier_post((unsigned*)a.ws, bst);


    REP_P0 { PV rope_table(ap, gw, ngw, lane); convert_group<0>(ap, lds, wave, lane, gw, ngw); convert_group<1>(ap, lds, wave, lane, gw, ngw); convert_group<2>(ap, lds, wave, lane, gw, ngw); convert_group<3>(ap, lds, wave, lane, gw, ngw); }
    { PV norm_phase(ap->in[0], ap->in[1], XRES, ap->in[7], XN_, nullptr, nullptr, nullptr, nullptr, nullptr, nullptr, nullptr, 0, nullptr, gw, ngw, lane); }
    GSYNC();

    layer_body<0>(lds); layer_body<1>(lds); layer_body<2>(lds); layer_body<3>(lds);
}

extern "C" void kernel_launch(void* const* d_in, const int* in_sizes, int n_in, void* d_out, int out_size, void* d_ws, size_t ws_size, hipStream_t stream) {
    static int grid = 0;
    if (grid == 0) {
        if (n_in != 25 || (size_t)out_size != OUT_TOTAL || ws_size < WS_TOTAL) {
            fprintf(stderr, "kernel_launch: unexpected shapes: n_in %d out %d ws %zu (need %zu)\n", n_in, out_size, ws_size, (size_t)WS_TOTAL); grid = -1; return; }
        int dev = 0, cus = 0, per_cu = 0;
        (void)hipGetDevice(&dev); (void)hipDeviceGetAttribute(&cus, hipDeviceAttributeMultiprocessorCount, dev);
        (void)hipFuncSetAttribute((const void*)mk_fwd, hipFuncAttributeMaxDynamicSharedMemorySize, LDS_BYTES);
        if (hipOccupancyMaxActiveBlocksPerMultiprocessor(&per_cu, (const void*)mk_fwd, NTHR, LDS_BYTES) != hipSuccess || per_cu < 1) per_cu = 1;
        (void)hipGetLastError();
        if (cus <= 0) cus = 256;
        grid = cus;
    }
    if (grid < 0) return;
    (void)hipMemsetAsync(d_ws, 0, 16384, stream);
    Args a{};
    for (int i = 0; i < 25; ++i) a.in[i] = (const float*)d_in[i];
    a.out = (float*)d_out; a.ws = (unsigned char*)d_ws;
    void* args[] = {&a};
    hipError_t e = hipLaunchCooperativeKernel((const void*)mk_fwd, dim3(grid), dim3(NTHR), args, LDS_BYTES, stream);
    if (e != hipSuccess) fprintf(stderr, "cooperative launch failed: %s (grid %d)\n", hipGetErrorString(e), grid);
}
```
